# Optimizing an MI355X kernel written in HIP

```python
import math
import jax, jax.numpy as jnp
from jax import lax
import numpy as np

D_MODEL = 1024
BATCH = 8
SEQ = 2048
DEPTH = 2

CTX_LEN = 256
GRID_W = 64
N_EVEN = (DEPTH + 1) // 2
N_ODD = DEPTH // 2
N_MOD = 9
D_FF = 2816
NORM_EPS = 1e-6
NEG_INF = -1e30
ROPE_BASE = 10000.0
NA_HEADS = 8
NA_HD = 64
NA_WIN_H = 8
NA_WIN_W = 16
NA_QB_W = 16
NA_KB_W = NA_QB_W + NA_WIN_W
NA_PROJ = 3 * NA_HEADS * NA_HD
DN_HEADS = 4
DN_DK = 128
DN_DV = 128
DN_CONV = 5
DN_CHUNK = 64
DN_QKV = DN_HEADS * (2 * DN_DK + DN_DV)
DN_PROJ = DN_QKV + DN_HEADS * DN_DV + 4 * DN_HEADS
EVEN_PROJ = NA_PROJ + DN_PROJ
EVEN_MIX_W = NA_HEADS * NA_HD + DN_HEADS * DN_DV
SWA_HEADS = 16
SWA_KV_HEADS = 4
SWA_HD = 64
SWA_WINDOW = 128
SWA_BLOCK = 128
ODD_PROJ = (SWA_HEADS + 2 * SWA_KV_HEADS) * SWA_HD
ODD_MIX_W = SWA_HEADS * SWA_HD

kernel_name = "hybrid_na_deltanet_swa_prefix_dit"


def rmsnorm(x, g):
    xf = x.astype(jnp.float32)
    y = xf * lax.rsqrt(jnp.mean(xf * xf, -1, keepdims=True) + NORM_EPS)
    return (y * g.astype(jnp.float32)).astype(x.dtype)


def l2norm(x):
    xf = x.astype(jnp.float32)
    return (xf * lax.rsqrt(jnp.sum(xf * xf, -1, keepdims=True) + NORM_EPS)).astype(x.dtype)


def modulate(h, g, shift, scale):
    return rmsnorm(h, g) * (1 + scale) + shift


def adaln_terms(s, w, b):
    return jnp.split(jax.nn.silu(s) @ w + b, N_MOD, -1)


def swiglu(x, w_up, w_down):
    gate, up = jnp.split(x @ w_up, 2, -1)
    return (jax.nn.silu(gate) * up) @ w_down


def axial_rope_tables(T):
    t = jnp.arange(T)
    half = SWA_HD // 2
    inv = jnp.power(ROPE_BASE, -jnp.arange(0, half, 2, dtype=jnp.float32) / half)
    ang_r = (t // GRID_W).astype(jnp.float32)[:, None] * inv
    ang_c = (t % GRID_W).astype(jnp.float32)[:, None] * inv
    return (jnp.cos(ang_r)[:, None, :], jnp.sin(ang_r)[:, None, :],
            jnp.cos(ang_c)[:, None, :], jnp.sin(ang_c)[:, None, :])


def rope_half(x, cos, sin):
    x1, x2 = jnp.split(x.astype(jnp.float32), 2, -1)
    return jnp.concatenate([x1 * cos - x2 * sin, x2 * cos + x1 * sin], -1)


def axial_rope(x, tabs):
    cr, sr, cc, sc = tabs
    xr, xc = jnp.split(x, 2, -1)
    return jnp.concatenate([rope_half(xr, cr, sr), rope_half(xc, cc, sc)], -1).astype(x.dtype)


def context_attention(qc, kc, vc, sink=None):
    B, Tc = qc.shape[:2]
    s = jnp.einsum('bqgrd,bkgd->bgrqk', qc, kc).astype(jnp.float32) * qc.shape[-1] ** -0.5
    if sink is not None:
        s = jnp.concatenate([s, jnp.broadcast_to(sink.astype(jnp.float32)[None, :, :, None, None], s.shape[:-1] + (1,))], -1)
    p = jax.nn.softmax(s, -1)[..., :kc.shape[1]].astype(vc.dtype)
    return jnp.einsum('bgrqk,bkgd->bqgrd', p, vc).reshape(B, Tc, -1)


def neighbourhood_attention(q, k, v, kc, vc, rpb):
    B, T, H, d = q.shape
    rows = T // GRID_W
    kh = min(NA_WIN_H, rows)
    ncb = GRID_W // NA_QB_W
    nwin = kh * NA_KB_W
    jb = jnp.arange(ncb)
    cidx = jnp.clip(jb * NA_QB_W - NA_WIN_W // 2, 0, GRID_W - NA_KB_W)[:, None] + jnp.arange(NA_KB_W)[None, :]
    qcol = jb[:, None] * NA_QB_W + jnp.arange(NA_QB_W)[None, :]
    cstart = jnp.clip(qcol - NA_WIN_W // 2, 0, GRID_W - NA_WIN_W)
    col_ok = (cidx[:, None, :] >= cstart[:, :, None]) & (cidx[:, None, :] < cstart[:, :, None] + NA_WIN_W)
    dc = jnp.clip(cidx[:, None, :] - qcol[:, :, None] + NA_WIN_W - 1, 0, 2 * NA_WIN_W - 2)
    kgrid = k.reshape(B, rows, GRID_W, H, d)
    vgrid = v.reshape(B, rows, GRID_W, H, d)
    q_rows = jnp.moveaxis(q.reshape(B, rows, ncb, NA_QB_W, H, d), 1, 0)
    rpb_f = rpb.astype(jnp.float32)
    scale = d ** -0.5

    def row_block(args):
        r, q_r = args
        r0 = jnp.clip(r - kh // 2, 0, rows - kh)
        k_r = lax.dynamic_slice_in_dim(kgrid, r0, kh, axis=1)[:, :, cidx]
        v_r = lax.dynamic_slice_in_dim(vgrid, r0, kh, axis=1)[:, :, cidx]
        dr = r0 + jnp.arange(kh) - r + NA_WIN_H - 1
        bias = rpb_f[:, dr[None, None, :, None], dc[:, :, None, :]]
        s_win = jnp.einsum('bjqhd,bajkhd->bhjqak', q_r, k_r).astype(jnp.float32) * scale + bias
        s_win = jnp.where(col_ok[:, :, None, :], s_win, NEG_INF).reshape(B, H, ncb, NA_QB_W, nwin)
        s_ctx = jnp.einsum('bjqhd,bchd->bhjqc', q_r, kc).astype(jnp.float32) * scale
        p = jax.nn.softmax(jnp.concatenate([s_win, s_ctx], -1), -1).astype(v.dtype)
        p_win = p[..., :nwin].reshape(B, H, ncb, NA_QB_W, kh, NA_KB_W)
        o = jnp.einsum('bhjqak,bajkhd->bjqhd', p_win, v_r) + jnp.einsum('bhjqc,bchd->bjqhd', p[..., nwin:], vc)
        return o.reshape(B, GRID_W, H * d)

    o = lax.map(row_block, (jnp.arange(rows), q_rows))
    return jnp.moveaxis(o, 0, 1).reshape(B, T, H * d)


def centred_short_conv(x, w):
    K = w.shape[0]
    T = x.shape[1]
    xp = jnp.pad(x, ((0, 0), (K // 2, K // 2), (0, 0)))
    return jax.nn.silu(sum(xp[:, j:j + T] * w[j] for j in range(K)))


def chunk_gated_delta_rule(q, k, v, g, beta, S0):
    B, T, H, dk = k.shape
    dv = v.shape[-1]
    C = DN_CHUNK
    N = T // C

    def chunks(t):
        return jnp.moveaxis(t.astype(jnp.float32).reshape((B, N, C) + t.shape[2:]), 3, 2)

    q = chunks(q) * dk ** -0.5
    k = chunks(k)
    v = chunks(v)
    beta = chunks(beta)
    g = jnp.cumsum(chunks(g), -1)
    idx = jnp.arange(C)
    incl = idx[:, None] >= idx[None, :]
    strict = idx[:, None] > idx[None, :]
    diff = g[..., :, None] - g[..., None, :]
    decay = jnp.where(incl, jnp.exp(jnp.where(incl, diff, 0.0)), 0.0)
    kb = k * beta[..., None]
    L = jnp.where(strict, jnp.einsum('bnhcd,bnhsd->bnhcs', kb, k) * decay, 0.0)
    A = L + jnp.eye(C, dtype=jnp.float32)
    rhs = jnp.concatenate([v * beta[..., None], kb * jnp.exp(g)[..., None]], -1)
    sol = lax.linalg.triangular_solve(A, rhs, left_side=True, lower=True, unit_diagonal=True)
    u, w = sol[..., :dv], sol[..., dv:]
    qk = jnp.einsum('bnhcd,bnhsd->bnhcs', q, k) * decay
    q_dec = q * jnp.exp(g)[..., None]
    k_dec = k * jnp.exp(g[..., -1:] - g)[..., None]
    g_last = jnp.exp(g[..., -1])

    def step(S, xs):
        q_i, k_i, u_i, w_i, qk_i, gl = xs
        v_new = u_i - jnp.einsum('bhcd,bhde->bhce', w_i, S)
        o = jnp.einsum('bhcd,bhde->bhce', q_i, S) + jnp.einsum('bhcs,bhse->bhce', qk_i, v_new)
        S = S * gl[..., None, None] + jnp.einsum('bhcd,bhce->bhde', k_i, v_new)
        return S, o

    xs = tuple(jnp.moveaxis(t, 1, 0) for t in (q_dec, k_dec, u, w, qk, g_last))
    S, o = lax.scan(step, S0.astype(jnp.float32), xs)
    o = jnp.moveaxis(jnp.moveaxis(o, 0, 1), 2, 3).reshape(B, T, H, dv)
    return o, S


def gated_rmsnorm(o, z, w):
    of = o.astype(jnp.float32)
    y = of * lax.rsqrt(jnp.mean(of * of, -1, keepdims=True) + NORM_EPS) * w.astype(jnp.float32) * jax.nn.silu(z.astype(jnp.float32))
    return y.astype(z.dtype).reshape(z.shape[0], z.shape[1], -1)


def maybe_flip(t, d):
    return jnp.flip(t, 1) if d else t


def gated_deltanet(p, pc, conv_w, a_log, dt_bias, norm_w, need_ctx):
    def prep(t):
        B, T, _ = t.shape
        qkv = centred_short_conv(t[..., :DN_QKV], conv_w)
        q, k, v = jnp.split(qkv, [DN_HEADS * DN_DK, 2 * DN_HEADS * DN_DK], -1)
        q = l2norm(q.reshape(B, T, DN_HEADS, DN_DK))
        k = l2norm(k.reshape(B, T, DN_HEADS, DN_DK))
        v = v.reshape(B, T, DN_HEADS, DN_DV)
        z = t[..., DN_QKV:DN_QKV + DN_HEADS * DN_DV].reshape(B, T, DN_HEADS, DN_DV)
        ab = t[..., DN_QKV + DN_HEADS * DN_DV:].astype(jnp.float32).reshape(B, T, 2, 2, DN_HEADS)
        g = -jnp.exp(a_log.astype(jnp.float32)) * jax.nn.softplus(ab[:, :, 0] + dt_bias.astype(jnp.float32))
        beta = jax.nn.sigmoid(ab[:, :, 1])
        return q, k, v, z, g, beta

    q, k, v, z, g, beta = prep(p)
    qc, kc, vc, zc, gc, betac = prep(pc)
    B = p.shape[0]
    S0 = jnp.zeros((B, DN_HEADS, DN_DK, DN_DV), jnp.float32)
    o = 0.0
    o_c = 0.0
    for d in range(2):
        oc_d, S_ctx = chunk_gated_delta_rule(maybe_flip(qc, d), maybe_flip(kc, d), maybe_flip(vc, d),
                                             maybe_flip(gc[:, :, d], d), maybe_flip(betac[:, :, d], d), S0)
        o_d, _ = chunk_gated_delta_rule(maybe_flip(q, d), maybe_flip(k, d), maybe_flip(v, d),
                                        maybe_flip(g[:, :, d], d), maybe_flip(beta[:, :, d], d), S_ctx)
        o = o + maybe_flip(o_d, d)
        if need_ctx:
            o_c = o_c + maybe_flip(oc_d, d)
    out = gated_rmsnorm(o, z, norm_w)
    out_c = gated_rmsnorm(o_c, zc, norm_w) if need_ctx else None
    return out, out_c


def even_mixer(u, uc, w_in, w_out, rpb, conv_w, a_log, dt_bias, dn_norm_w, need_ctx):
    B, T, _ = u.shape
    Tc = uc.shape[1]
    p = u @ w_in
    pc = uc @ w_in
    q, k, v = [t.reshape(B, T, NA_HEADS, NA_HD) for t in jnp.split(p[..., :NA_PROJ], 3, -1)]
    qc, kc, vc = [t.reshape(B, Tc, NA_HEADS, NA_HD) for t in jnp.split(pc[..., :NA_PROJ], 3, -1)]
    y_na = neighbourhood_attention(q, k, v, kc, vc, rpb)
    y_dn, y_dn_c = gated_deltanet(p[..., NA_PROJ:], pc[..., NA_PROJ:], conv_w, a_log, dt_bias, dn_norm_w, need_ctx)
    y = jnp.concatenate([y_na, y_dn], -1) @ w_out
    if not need_ctx:
        return y, None
    y_na_c = context_attention(qc[:, :, :, None, :], kc, vc)
    yc = jnp.concatenate([y_na_c, y_dn_c], -1) @ w_out
    return y, yc


def windowed_gqa_sink(q, k, v, kc, vc, sink):
    B, T, Hq, d = q.shape
    G = k.shape[2]
    R = Hq // G
    nb = T // SWA_BLOCK
    pad = ((0, 0), (SWA_BLOCK, SWA_BLOCK), (0, 0), (0, 0))
    kp = jnp.pad(k, pad)
    vp = jnp.pad(v, pad)
    qb = jnp.moveaxis(q.reshape(B, nb, SWA_BLOCK, G, R, d), 1, 0)
    qi = jnp.arange(SWA_BLOCK)
    ki = jnp.arange(3 * SWA_BLOCK) - SWA_BLOCK
    rel = ki[None, :] - qi[:, None]
    sink_f = sink.astype(jnp.float32).reshape(G, R)
    scale = d ** -0.5
    nwin = 3 * SWA_BLOCK
    Tc = kc.shape[1]

    def block(args):
        n, q_n = args
        k_n = lax.dynamic_slice_in_dim(kp, n * SWA_BLOCK, nwin, axis=1)
        v_n = lax.dynamic_slice_in_dim(vp, n * SWA_BLOCK, nwin, axis=1)
        kpos = n * SWA_BLOCK + ki
        ok = (jnp.abs(rel) <= SWA_WINDOW) & ((kpos >= 0) & (kpos < T))[None, :]
        s_win = jnp.where(ok, jnp.einsum('bqgrd,bkgd->bgrqk', q_n, k_n).astype(jnp.float32) * scale, NEG_INF)
        s_ctx = jnp.einsum('bqgrd,bcgd->bgrqc', q_n, kc).astype(jnp.float32) * scale
        s_sink = jnp.broadcast_to(sink_f[None, :, :, None, None], s_ctx.shape[:-1] + (1,))
        p = jax.nn.softmax(jnp.concatenate([s_win, s_ctx, s_sink], -1), -1).astype(v.dtype)
        o = (jnp.einsum('bgrqk,bkgd->bqgrd', p[..., :nwin], v_n)
             + jnp.einsum('bgrqc,bcgd->bqgrd', p[..., nwin:nwin + Tc], vc))
        return o.reshape(B, SWA_BLOCK, Hq * d)

    o = lax.map(block, (jnp.arange(nb), qb))
    return jnp.moveaxis(o, 0, 1).reshape(B, T, Hq * d)


def odd_mixer(u, uc, w_in, w_out, sink, rope, need_ctx):
    B, T, _ = u.shape
    Tc = uc.shape[1]
    QW = SWA_HEADS * SWA_HD
    KW = SWA_KV_HEADS * SWA_HD
    R = SWA_HEADS // SWA_KV_HEADS
    p = u @ w_in
    q = axial_rope(p[..., :QW].reshape(B, T, SWA_HEADS, SWA_HD), rope)
    k = axial_rope(p[..., QW:QW + KW].reshape(B, T, SWA_KV_HEADS, SWA_HD), rope)
    v = p[..., QW + KW:].reshape(B, T, SWA_KV_HEADS, SWA_HD)
    kvc = uc @ w_in[:, QW:]
    kc = kvc[..., :KW].reshape(B, Tc, SWA_KV_HEADS, SWA_HD)
    vc = kvc[..., KW:].reshape(B, Tc, SWA_KV_HEADS, SWA_HD)
    y = windowed_gqa_sink(q, k, v, kc, vc, sink) @ w_out
    if not need_ctx:
        return y, None
    qc = (uc @ w_in[:, :QW]).reshape(B, Tc, SWA_KV_HEADS, R, SWA_HD)
    yc = context_attention(qc, kc, vc, sink.reshape(SWA_KV_HEADS, R)) @ w_out
    return y, yc


def setup_inputs(seed: int = 0) -> dict:
    key = jax.random.key(seed)
    ks = jax.random.split(key, 20)
    f32 = jnp.float32

    def nrm(k, shape, fan_in, gain=1.0):
        return jax.random.normal(k, shape, f32) * (gain * fan_in ** -0.5)

    dt = jnp.exp(jax.random.uniform(ks[14], (N_EVEN, 2, DN_HEADS), f32, math.log(1e-3), math.log(1e-1)))
    return {
        "x": jax.random.normal(ks[0], (BATCH, SEQ, D_MODEL), f32),
        "c": jax.random.normal(ks[1], (BATCH, D_MODEL), f32),
        "ctx": jax.random.normal(ks[2], (BATCH, CTX_LEN, D_MODEL), f32),
        "c_ctx": jax.random.normal(ks[3], (D_MODEL,), f32),
        "ada_w": nrm(ks[4], (DEPTH, D_MODEL, N_MOD * D_MODEL), D_MODEL, 0.5),
        "ada_b": 0.02 * jax.random.normal(ks[5], (DEPTH, N_MOD * D_MODEL), f32),
        "norm_g": 1.0 + 0.02 * jax.random.normal(ks[6], (DEPTH, 3, D_MODEL), f32),
        "ffn_w_up": nrm(ks[7], (DEPTH, 2, D_MODEL, 2 * D_FF), D_MODEL),
        "ffn_w_down": nrm(ks[8], (DEPTH, 2, D_FF, D_MODEL), D_FF),
        "even_w_in": nrm(ks[9], (N_EVEN, D_MODEL, EVEN_PROJ), D_MODEL),
        "even_w_out": nrm(ks[10], (N_EVEN, EVEN_MIX_W, D_MODEL), EVEN_MIX_W),
        "na_rpb": 0.1 * jax.random.normal(ks[11], (N_EVEN, NA_HEADS, 2 * NA_WIN_H - 1, 2 * NA_WIN_W - 1), f32),
        "dn_conv_w": nrm(ks[12], (N_EVEN, DN_CONV, DN_QKV), DN_CONV),
        "dn_a_log": jnp.log(jax.random.uniform(ks[13], (N_EVEN, 2, DN_HEADS), f32, 1.0, 16.0)),
        "dn_dt_bias": dt + jnp.log(-jnp.expm1(-dt)),
        "dn_norm_w": 1.0 + 0.02 * jax.random.normal(ks[15], (N_EVEN, DN_DV), f32),
        "odd_w_in": nrm(ks[16], (N_ODD, D_MODEL, ODD_PROJ), D_MODEL),
        "odd_w_out": nrm(ks[17], (N_ODD, ODD_MIX_W, D_MODEL), ODD_MIX_W),
        "swa_sink": jax.random.normal(ks[18], (N_ODD, SWA_HEADS), f32),
        "final_norm_g": 1.0 + 0.02 * jax.random.normal(ks[19], (D_MODEL,), f32),
    }


def reference(x, c, ctx, c_ctx, ada_w, ada_b, norm_g, ffn_w_up, ffn_w_down, even_w_in, even_w_out, na_rpb,
              dn_conv_w, dn_a_log, dn_dt_bias, dn_norm_w, odd_w_in, odd_w_out, swa_sink, final_norm_g):
    T = x.shape[1]
    rope = axial_rope_tables(T)
    h, hc = x, ctx
    for i in range(DEPTH):
        need_ctx = i < DEPTH - 1
        j = i // 2
        ml = adaln_terms(c[:, None, :], ada_w[i], ada_b[i])
        mc = adaln_terms(c_ctx, ada_w[i], ada_b[i])
        h = h + 0.5 * ml[2] * swiglu(modulate(h, norm_g[i, 0], ml[0], ml[1]), ffn_w_up[i, 0], ffn_w_down[i, 0])
        hc = hc + 0.5 * mc[2] * swiglu(modulate(hc, norm_g[i, 0], mc[0], mc[1]), ffn_w_up[i, 0], ffn_w_down[i, 0])
        u = modulate(h, norm_g[i, 1], ml[3], ml[4])
        uc = modulate(hc, norm_g[i, 1], mc[3], mc[4])
        if i % 2 == 0:
            y, yc = even_mixer(u, uc, even_w_in[j], even_w_out[j], na_rpb[j], dn_conv_w[j], dn_a_log[j],
                               dn_dt_bias[j], dn_norm_w[j], need_ctx)
        else:
            y, yc = odd_mixer(u, uc, odd_w_in[j], odd_w_out[j], swa_sink[j], rope, need_ctx)
        h = h + ml[5] * y
        h = h + 0.5 * ml[8] * swiglu(modulate(h, norm_g[i, 2], ml[6], ml[7]), ffn_w_up[i, 1], ffn_w_down[i, 1])
        if need_ctx:
            hc = hc + mc[5] * yc
            hc = hc + 0.5 * mc[8] * swiglu(modulate(hc, norm_g[i, 2], mc[6], mc[7]), ffn_w_up[i, 1], ffn_w_down[i, 1])
    return rmsnorm(h, final_norm_g)
```

```cpp
#include <hip/hip_runtime.h>
#include <hip/hip_cooperative_groups.h>
#include <cstdio>
#include <cstdint>
namespace cg = cooperative_groups;
namespace pg8 {
#define PG8_LAS __attribute__((address_space(3)))
typedef unsigned short bf16_t;
typedef short bf16x8 __attribute__((ext_vector_type(8)));
typedef float f32x4 __attribute__((ext_vector_type(4)));
typedef unsigned u32x4 __attribute__((ext_vector_type(4)));
constexpr int BM = 256, BK = 64, HALF = 128, HTB = HALF * BK * 2  , STAGE_BYTES = 8 * HTB, NXCD = 8, WGM = 4;

__host__ __device__ __forceinline__ int lds_byte(int r, int c) { const int st = (r >> 4) * 2 + (c >> 5), rr = r & 15, cc = c & 31, ob = rr * 64 + cc * 2; return st * 1024 + (ob ^ (((ob >> 9) & 1) << 5)); }
__host__ __device__ __forceinline__ void stage_rc(int b, int& R, int& C) { const int st = b / 1024, sb = b % 1024, swz = sb ^ (((sb >> 9) & 1) << 5); R = (st >> 1) * 16 + swz / 64; C = (st & 1) * 32 + (swz % 64) / 2; }
__host__ __device__ __forceinline__ int perm32(int rho) { const int n = rho >> 4, i = rho & 15; return 8 * (i >> 2) + 4 * n + (i & 3); }

struct Unit { int pm, pn; };
struct Gemm { const bf16_t* A; const bf16_t* Bt; int M, N, K; };

struct StaticOrder {
    int nM, nN, nwg, G, c;
    __host__ __device__ void init(int M, int N, int G_, int c_) { nM = M / BM; nN = N / BM; nwg = nM * nN; G = G_; c = c_; }
    __host__ __device__ bool next(int i, Unit& u) const {
        const long L = (long)i * G + c; if (L >= nwg) return false;
        int wgid = (int)L; { const int q = nwg / NXCD, r = nwg % NXCD, xcd = wgid % NXCD, off = wgid / NXCD; wgid = (xcd < r ? xcd * (q + 1) : r * (q + 1) + (xcd - r) * q) + off; }
        const int nig = WGM * nN, gid = wgid / nig, fm = gid * WGM, gsz = (nM - fm) < WGM ? (nM - fm) : WGM;
        u.pm = fm + ((wgid % nig) % gsz); u.pn = (wgid % nig) / gsz; return true;
    }
    __device__ __forceinline__ void a_ready(const Unit&) const {}
    __device__ __forceinline__ void done(const Unit&) const {}
};

template <class Epi, class Sched, bool ALIGN_EPI = false, bool SP2 = false>
__device__ __forceinline__ void gemm_phase(PG8_LAS unsigned char* lds, const Gemm g, const Sched& S, const Epi& E) {
    int tid_l = threadIdx.x; asm volatile("" : "+v"(tid_l));
    const int tid = tid_l, wid = __builtin_amdgcn_readfirstlane(tid >> 6), lane = tid & 63, wr = wid >> 2, wc = wid & 3, fr = lane & 15, fq = lane >> 4;
    const int K = g.K, nt = K / BK;
    unsigned voffA[2], voffB[2];
#pragma unroll
    for (int i = 0; i < 2; ++i) { int R, C; stage_rc(tid * 16 + i * 8192, R, C); const int Rb = Epi::PERM ? ((R & ~31) + perm32(R & 31)) : R;
        voffA[i] = (unsigned)(R * K + C) * 2u; voffB[i] = (unsigned)(Rb * K + C) * 2u; }
    const size_t kstep = (size_t)(BK * 2);
    const size_t hstep = (size_t)HALF * K * 2;
    const size_t tstep = 2 * hstep;
    const unsigned ldsw = (unsigned)wid * 1024u;
    const int aoff = lds_byte(wr * 64 + fr, fq * 8), boff = lds_byte(wc * 32 + fr, fq * 8);
#define PG8_SA(b, h) (((b) * 2 + (h)) * HTB)
#define PG8_SB(b, h) ((4 + (b) * 2 + (h)) * HTB)
#define PG8_STAGE(bufoff, gbase, voff) do { _Pragma("unroll") for (int _i = 0; _i < 2; ++_i) \
        __builtin_amdgcn_global_load_lds((const unsigned*)((const char*)(gbase) + (voff)[_i]), (PG8_LAS unsigned*)(lds + (bufoff) + ldsw + _i * 8192), 16, 0, 0); } while (0)
#define PG8_LDA(dst, b, h) do { _Pragma("unroll") for (int m = 0; m < 4; ++m) _Pragma("unroll") for (int k = 0; k < 2; ++k) dst[m][k] = *(const PG8_LAS bf16x8*)(lds + PG8_SA(b, h) + aoff + m * 2048 + k * 1024); } while (0)
#define PG8_LDB(dst, b, h) do { _Pragma("unroll") for (int n = 0; n < 2; ++n) _Pragma("unroll") for (int k = 0; k < 2; ++k) dst[n][k] = *(const PG8_LAS bf16x8*)(lds + PG8_SB(b, h) + boff + n * 2048 + k * 1024); } while (0)
#define PG8_MMA(ai, bj, At, Bt) do { __builtin_amdgcn_s_setprio(1); _Pragma("unroll") for (int m = 0; m < 4; ++m) _Pragma("unroll") for (int n = 0; n < 2; ++n) _Pragma("unroll") for (int k = 0; k < 2; ++k) \
        acc[ai][bj][m][n] = __builtin_amdgcn_mfma_f32_16x16x32_bf16(Bt[n][k], At[m][k], acc[ai][bj][m][n], 0, 0, 0); __builtin_amdgcn_s_setprio(0); } while (0)
#define PG8_WAIT_V(n) asm volatile("s_waitcnt vmcnt(" #n ")" ::: "memory")
#define PG8_WAIT_L(n) asm volatile("s_waitcnt lgkmcnt(" #n ")" ::: "memory")
#define PG8_BAR __builtin_amdgcn_s_barrier()
#define PG8_SCHED __builtin_amdgcn_sched_barrier(0)
    Unit cur, nxt; int ui = 0;
    if (!S.next(0, cur)) return;
    f32x4 acc[2][2][4][2];
#pragma unroll
    for (int a = 0; a < 2; ++a)
#pragma unroll
        for (int b = 0; b < 2; ++b)
#pragma unroll
            for (int m = 0; m < 4; ++m)
#pragma unroll
                for (int n = 0; n < 2; ++n) acc[a][b][m][n] = (f32x4){0.f, 0.f, 0.f, 0.f};
    bf16x8 At[4][2], B0[2][2], B1[2][2];
    const char* cA = (const char*)g.A + (size_t)cur.pm * tstep; const char* cB = (const char*)g.Bt + (size_t)cur.pn * tstep;
    S.a_ready(cur);
    if constexpr (SP2) {
        PG8_STAGE(PG8_SB(0, 0), cB, voffB); PG8_STAGE(PG8_SB(0, 1), cB + hstep, voffB); PG8_STAGE(PG8_SA(0, 0), cA, voffA); PG8_STAGE(PG8_SA(0, 1), cA + hstep, voffA);
        if (wr == 1) PG8_BAR;
        PG8_WAIT_V(2); PG8_BAR;
        PG8_STAGE(PG8_SB(1, 0), cB + kstep, voffB); PG8_STAGE(PG8_SA(1, 0), cA + kstep, voffA); PG8_STAGE(PG8_SB(1, 1), cB + hstep + kstep, voffB);
        PG8_WAIT_V(6); PG8_BAR;
    } else {
        PG8_STAGE(PG8_SB(0, 0), cB, voffB); PG8_STAGE(PG8_SA(0, 0), cA, voffA); PG8_STAGE(PG8_SB(0, 1), cB + hstep, voffB); PG8_STAGE(PG8_SA(0, 1), cA + hstep, voffA);
        if (wr == 1) PG8_BAR;
        PG8_WAIT_V(4); PG8_BAR;
        PG8_STAGE(PG8_SB(1, 0), cB + kstep, voffB); PG8_STAGE(PG8_SA(1, 0), cA + kstep, voffA); PG8_STAGE(PG8_SB(1, 1), cB + hstep + kstep, voffB);
        PG8_WAIT_V(6); PG8_BAR;
    }
    for (;;) {
        const bool has_next = S.next(ui + 1, nxt);
        const char* nA = has_next ? (const char*)g.A + (size_t)nxt.pm * tstep : cA; const char* nB = has_next ? (const char*)g.Bt + (size_t)nxt.pn * tstep : cB;
        for (int t = 0; t < nt; t += 2) {
            const bool last = (t == nt - 2);
            const char* a1 = cA + (size_t)(t + 1) * kstep;
            const char* a2 = last ? nA : cA + (size_t)(t + 2) * kstep; const char* b2 = last ? nB : cB + (size_t)(t + 2) * kstep;
            const char* a3 = a2 + kstep; const char* b3 = b2 + kstep;
            if (last && has_next) S.a_ready(nxt);
            if constexpr (SP2) {
            PG8_LDB(B0, 0, 0); PG8_LDB(B1, 0, 1); PG8_SCHED; PG8_LDA(At, 0, 0); PG8_STAGE(PG8_SA(1, 1), a1 + hstep, voffA);
            PG8_WAIT_V(8); PG8_WAIT_L(0); PG8_BAR; PG8_MMA(0, 0, At, B0); PG8_MMA(0, 1, At, B1); PG8_BAR; PG8_SCHED;
            PG8_LDA(At, 0, 1); PG8_STAGE(PG8_SB(0, 0), b2, voffB); PG8_STAGE(PG8_SB(0, 1), b2 + hstep, voffB); PG8_STAGE(PG8_SA(0, 0), a2, voffA);
            PG8_WAIT_V(8); PG8_WAIT_L(0); PG8_BAR; PG8_MMA(1, 0, At, B0); PG8_MMA(1, 1, At, B1); PG8_BAR; PG8_SCHED;
            PG8_LDB(B0, 1, 0); PG8_LDB(B1, 1, 1); PG8_SCHED; PG8_LDA(At, 1, 0); PG8_STAGE(PG8_SA(0, 1), a2 + hstep, voffA);
            PG8_WAIT_V(8); PG8_WAIT_L(0); PG8_BAR; PG8_MMA(0, 0, At, B0); PG8_MMA(0, 1, At, B1); PG8_BAR; PG8_SCHED;
            PG8_LDA(At, 1, 1); PG8_STAGE(PG8_SB(1, 0), b3, voffB); PG8_STAGE(PG8_SB(1, 1), b3 + hstep, voffB); PG8_STAGE(PG8_SA(1, 0), a3, voffA);
            PG8_WAIT_V(8); PG8_WAIT_L(0); PG8_BAR; PG8_MMA(1, 0, At, B0); PG8_MMA(1, 1, At, B1); PG8_BAR; PG8_SCHED;
            } else {
            PG8_LDB(B0, 0, 0); PG8_SCHED; PG8_LDA(At, 0, 0); PG8_STAGE(PG8_SA(1, 1), a1 + hstep, voffA);
            PG8_WAIT_L(8); PG8_BAR; PG8_WAIT_L(0); PG8_MMA(0, 0, At, B0); PG8_BAR; PG8_SCHED;
            PG8_LDB(B1, 0, 1); PG8_STAGE(PG8_SB(0, 0), b2, voffB);
            PG8_BAR; PG8_WAIT_L(0); PG8_MMA(0, 1, At, B1); PG8_BAR;
            PG8_LDA(At, 0, 1); PG8_STAGE(PG8_SA(0, 0), a2, voffA);
            PG8_BAR; PG8_WAIT_L(0); PG8_MMA(1, 0, At, B0); PG8_BAR; PG8_SCHED;
            PG8_STAGE(PG8_SB(0, 1), b2 + hstep, voffB);
            PG8_WAIT_V(6); PG8_BAR; PG8_MMA(1, 1, At, B1); PG8_BAR;
            PG8_LDB(B0, 1, 0); PG8_SCHED; PG8_LDA(At, 1, 0); PG8_STAGE(PG8_SA(0, 1), a2 + hstep, voffA);
            PG8_WAIT_L(8); PG8_BAR; PG8_WAIT_L(0); PG8_MMA(0, 0, At, B0); PG8_BAR; PG8_SCHED;
            PG8_LDB(B1, 1, 1); PG8_STAGE(PG8_SB(1, 0), b3, voffB);
            PG8_BAR; PG8_WAIT_L(0); PG8_MMA(0, 1, At, B1); PG8_BAR;
            PG8_LDA(At, 1, 1); PG8_STAGE(PG8_SA(1, 0), a3, voffA);
            PG8_BAR; PG8_WAIT_L(0); PG8_MMA(1, 0, At, B0); PG8_BAR; PG8_SCHED;
            PG8_STAGE(PG8_SB(1, 1), b3 + hstep, voffB);
            PG8_WAIT_V(6); PG8_BAR; PG8_MMA(1, 1, At, B1); PG8_BAR;
            }
        }
        if constexpr (ALIGN_EPI) { if (wr == 0) PG8_BAR; }
        if constexpr (!Epi::AFTER_DRAIN) { E(acc, cur, wr, wc, fr, fq); S.done(cur); }
        if (!has_next) break;
#pragma unroll
        for (int a = 0; a < 2; ++a)
#pragma unroll
            for (int b = 0; b < 2; ++b)
#pragma unroll
                for (int m = 0; m < 4; ++m)
#pragma unroll
                    for (int n = 0; n < 2; ++n) acc[a][b][m][n] = (f32x4){0.f, 0.f, 0.f, 0.f};
        cur = nxt; cA = nA; cB = nB; ++ui;
        if constexpr (ALIGN_EPI) { if (wr == 1) PG8_BAR; }
    }
    PG8_WAIT_V(0);
    if constexpr (!ALIGN_EPI) { if (wr == 0) PG8_BAR; }
    PG8_BAR;
    if constexpr (Epi::AFTER_DRAIN) { E.fused(acc, cur, wr, wc, fr, fq, lds, wid, lane); S.done(cur); }
#undef PG8_SA
#undef PG8_SB
#undef PG8_STAGE
#undef PG8_LDA
#undef PG8_LDB
#undef PG8_MMA
#undef PG8_WAIT_V
#undef PG8_WAIT_L
#undef PG8_BAR
#undef PG8_SCHED
}
}

using pg8::bf16_t; using pg8::bf16x8; using pg8::f32x4; using pg8::Unit;
typedef unsigned u32x4 __attribute__((ext_vector_type(4)));
typedef unsigned u32x2 __attribute__((ext_vector_type(2)));
typedef short s16x4 __attribute__((ext_vector_type(4)));

constexpr int DM = 1024, NBATCH = 8, TLAT = 2048, TCTX = 256, MLAT = 16384, MALL = 18432, DFF = 2816, TT = 2304;
constexpr float EPS = 1e-6f;
constexpr float SCALE_DK = 0.08838834764831845f;
constexpr int NTHREADS = 512;
constexpr int LDS_BYTES = 156672;
constexpr int LDS_MISC = 155648;

constexpr size_t MiB = 1u << 20;
constexpr size_t WS_MOD = 1 * MiB;
constexpr size_t WS_WUP = 2 * MiB;
constexpr size_t WS_WDN = 46 * MiB;
constexpr size_t WS_WEIN = 68 * MiB;
constexpr size_t WS_WEOUT = 76 * MiB;
constexpr size_t WS_WOIN = 78 * MiB;
constexpr size_t WS_WOOUT = 81 * MiB;
constexpr size_t WS_HCTX = 83 * MiB;
constexpr size_t WS_A = 91 * MiB;
constexpr size_t WS_ACT = 127 * MiB;
constexpr size_t WS_NAQK = 127 * MiB;
constexpr size_t WS_NAVT = 163 * MiB;
constexpr size_t WS_DNPRE = 181 * MiB;
constexpr size_t WS_Z = 235 * MiB;
constexpr size_t WS_AB = 253 * MiB;
constexpr size_t WS_GB = 255 * MiB;
constexpr size_t WS_QN = 257 * MiB;
constexpr size_t WS_KN = 275 * MiB;
constexpr size_t WS_VV = 293 * MiB;
constexpr size_t WS_RSCS = 311 * MiB;
constexpr size_t WS_O = 314 * MiB;
constexpr size_t WS_NEGW = 127 * MiB;
constexpr size_t WS_UT = 163 * MiB;
constexpr size_t WS_QKC = 199 * MiB;
constexpr size_t WS_KNT = 217 * MiB;
constexpr size_t WS_SWQ = 127 * MiB;
constexpr size_t WS_SWK = 159 * MiB;
constexpr size_t WS_SWVT = 168 * MiB;

struct P {
    const float *x, *c, *ctx, *c_ctx, *ada_w, *ada_b, *norm_g, *w_up, *w_dn, *e_in, *e_out, *rpb, *conv_w, *a_log, *dt_bias, *dn_norm_w, *o_in, *o_out, *sink, *fin_g;
    float* out; unsigned char* ws;
};

__device__ __forceinline__ unsigned f2bf(float f) { unsigned u = __builtin_bit_cast(unsigned, f); return (u + 0x7fffu + ((u >> 16) & 1u)) >> 16; }
__device__ __forceinline__ unsigned pk2(float lo, float hi) { unsigned r; asm("v_cvt_pk_bf16_f32 %0, %1, %2" : "=v"(r) : "v"(lo), "v"(hi)); return r; }
__device__ __forceinline__ float bf2f(unsigned short h) { return __builtin_bit_cast(float, (unsigned)h << 16); }
__device__ __forceinline__ float bflo(unsigned w) { return __builtin_bit_cast(float, w << 16); }
__device__ __forceinline__ float bfhi(unsigned w) { return __builtin_bit_cast(float, w & 0xffff0000u); }
__device__ __forceinline__ float wave_sum(float v) {
#pragma unroll
    for (int o = 1; o < 64; o <<= 1) v += __shfl_xor(v, o);
    return v;
}
__device__ __forceinline__ float xmax32(float x) { unsigned a = __builtin_bit_cast(unsigned, x), b = a; asm volatile("" : "+v"(b)); auto r = __builtin_amdgcn_permlane32_swap(a, b, false, false); return fmaxf(__builtin_bit_cast(float, (unsigned)r[0]), __builtin_bit_cast(float, (unsigned)r[1])); }
__device__ __forceinline__ float xmax16(float x) { unsigned a = __builtin_bit_cast(unsigned, x), b = a; asm volatile("" : "+v"(b)); auto r = __builtin_amdgcn_permlane16_swap(a, b, false, false); return fmaxf(__builtin_bit_cast(float, (unsigned)r[0]), __builtin_bit_cast(float, (unsigned)r[1])); }
__device__ __forceinline__ float siluf(float v) { return v * __builtin_amdgcn_rcpf(1.f + __expf(-v)); }
__device__ __forceinline__ f32x4 mfma16(bf16x8 a, bf16x8 b, f32x4 c) { return __builtin_amdgcn_mfma_f32_16x16x32_bf16(a, b, c, 0, 0, 0); }

struct EpiSwiglu {
    static constexpr bool PERM = false, AFTER_DRAIN = false;
    bf16_t* act;
    __device__ __forceinline__ void operator()(const f32x4 (&acc)[2][2][4][2], const Unit& u, int wr, int wc, int fr, int fq) const {
#pragma unroll
        for (int ai = 0; ai < 2; ++ai)
#pragma unroll
            for (int m = 0; m < 4; ++m) {
                const int row = u.pm * 256 + ai * 128 + wr * 64 + m * 16 + fr;
                const f32x4 g0 = acc[ai][0][m][0], u0 = acc[ai][0][m][1], g1 = acc[ai][1][m][0], u1 = acc[ai][1][m][1];
                u32x4 w;
                w.x = pk2(siluf(g0[0]) * u0[0], siluf(g0[1]) * u0[1]); w.y = pk2(siluf(g0[2]) * u0[2], siluf(g0[3]) * u0[3]);
                w.z = pk2(siluf(g1[0]) * u1[0], siluf(g1[1]) * u1[1]); w.w = pk2(siluf(g1[2]) * u1[2], siluf(g1[3]) * u1[3]);
                *(u32x4*)(act + (size_t)row * DFF + u.pn * 128 + wc * 32 + 8 * fq) = w;
            }
    }
};
struct EpiResid {
    static constexpr bool PERM = false, AFTER_DRAIN = false;
    const float* srclat; const float* srcctx; float* dstlat; float* dstctx; const float* gate; float scale;
    __device__ __forceinline__ void operator()(const f32x4 (&acc)[2][2][4][2], const Unit& u, int wr, int wc, int fr, int fq) const {
        const bool lat = u.pm < 64; const int mr = lat ? (u.pm >> 3) : 8;
        const float* sp = lat ? srclat : srcctx; float* dp = lat ? dstlat : dstctx;
        const int col0 = u.pn * 256 + wc * 32 + 8 * fq;
        const size_t off0 = (size_t)((lat ? u.pm : u.pm - 64) * 256 + wr * 64 + fr) * DM + col0;
        sp += off0; dp += off0;
        const float* gp = gate + (size_t)mr * 9216 + col0;
        f32x4 gv[2][2];
#pragma unroll
        for (int bj = 0; bj < 2; ++bj)
#pragma unroll
            for (int n = 0; n < 2; ++n) gv[bj][n] = *(const f32x4*)(gp + bj * 128 + n * 4) * scale;
#pragma unroll
        for (int ai = 0; ai < 2; ++ai)
#pragma unroll
            for (int m = 0; m < 4; ++m) {
                const int ro = (ai * 128 + m * 16) * DM;
                f32x4 s[2][2];
#pragma unroll
                for (int bj = 0; bj < 2; ++bj)
#pragma unroll
                    for (int n = 0; n < 2; ++n) s[bj][n] = *(const f32x4*)(sp + ro + bj * 128 + n * 4);
#pragma unroll
                for (int bj = 0; bj < 2; ++bj)
#pragma unroll
                    for (int n = 0; n < 2; ++n) *(f32x4*)(dp + ro + bj * 128 + n * 4) = s[bj][n] + gv[bj][n] * acc[ai][bj][m][n];
                asm volatile("" ::: "memory");
            }
    }
};
struct EpiEvenIn {
    static constexpr bool PERM = false, AFTER_DRAIN = false;
    bf16_t* naqk; bf16_t* navt; bf16_t* dnpre; bf16_t* z; float* ab;
    __device__ __forceinline__ void operator()(const f32x4 (&acc)[2][2][4][2], const Unit& u, int wr, int wc, int fr, int fq) const {
        const bool lat = u.pm < 64; const int b = lat ? (u.pm >> 3) : (u.pm - 64); const int tokb = lat ? (u.pm & 7) * 256 : 2048;
        const int rl0 = wr * 64 + fr; const int cl0 = wc * 32 + 4 * fq;
        if (u.pn >= 4 && u.pn < 6) {
            bf16_t* vp = navt + ((size_t)b * 512 + (u.pn - 4) * 256 + cl0) * TT + tokb + rl0;
#pragma unroll
            for (int ai = 0; ai < 2; ++ai)
#pragma unroll
                for (int m = 0; m < 4; ++m) {
#pragma unroll
                    for (int bj = 0; bj < 2; ++bj)
#pragma unroll
                        for (int n = 0; n < 2; ++n) {
                            const f32x4 v = acc[ai][bj][m][n];
#pragma unroll
                            for (int j = 0; j < 4; ++j) vp[(size_t)(bj * 128 + n * 16 + j) * TT + ai * 128 + m * 16] = (bf16_t)f2bf(v[j]);
                        }
                    asm volatile("" ::: "memory");
                }
        } else if (u.pn < 14) {
            bf16_t* base; int ld;
            if (u.pn < 4) { base = naqk + u.pn * 256; ld = 1024; } else if (u.pn < 12) { base = dnpre + (u.pn - 6) * 256; ld = 1536; } else { base = z + (u.pn - 12) * 256; ld = 512; }
            base += (size_t)(u.pm * 256 + rl0) * ld + wc * 32 + 8 * fq;
#pragma unroll
            for (int ai = 0; ai < 2; ++ai)
#pragma unroll
                for (int m = 0; m < 4; ++m) {
                    bf16_t* rp = base + (size_t)(ai * 128 + m * 16) * ld;
#pragma unroll
                    for (int bj = 0; bj < 2; ++bj) { const f32x4 v0 = acc[ai][bj][m][0], v1 = acc[ai][bj][m][1];
                        u32x4 w; w.x = pk2(v0[0], v0[1]); w.y = pk2(v0[2], v0[3]); w.z = pk2(v1[0], v1[1]); w.w = pk2(v1[2], v1[3]); *(u32x4*)(rp + bj * 128) = w; }
                    asm volatile("" ::: "memory");
                }
        } else if (wc == 0) {
            float* rp0 = ab + (size_t)(u.pm * 256 + rl0) * 16 + 4 * fq;
#pragma unroll
            for (int ai = 0; ai < 2; ++ai)
#pragma unroll
                for (int m = 0; m < 4; ++m) *(f32x4*)(rp0 + (size_t)(ai * 128 + m * 16) * 16) = acc[ai][0][m][0];
        }
    }
};
struct EpiOddIn {
    static constexpr bool PERM = false, AFTER_DRAIN = false;
    bf16_t* swq; bf16_t* swk; bf16_t* swvt; int pm0, pn0;
    __device__ __forceinline__ void operator()(const f32x4 (&acc)[2][2][4][2], const Unit& u, int wr, int wc, int fr, int fq) const {
        const int pm = u.pm + pm0, pn = u.pn + pn0;
        const bool lat = pm < 64; const int b = lat ? (pm >> 3) : (pm - 64); const int tokb = lat ? (pm & 7) * 256 : 2048;
        const int rl0 = wr * 64 + fr, cl0 = wc * 32 + 4 * fq;
        if (pn < 5) {
            bf16_t* base; int ld;
            if (pn < 4) { base = swq + pn * 256; ld = 1024; } else { base = swk; ld = 256; }
            base += (size_t)(pm * 256 + rl0) * ld + cl0;
            const float rot = lat ? 1.f : 0.f;
#pragma unroll
            for (int ai = 0; ai < 2; ++ai)
#pragma unroll
                for (int m = 0; m < 4; ++m) {
                    const int tok = tokb + rl0 + ai * 128 + m * 16;
                    const float pos = rot * (float)((wc & 1) ? (tok & 63) : (tok >> 6));
                    bf16_t* rp = base + (size_t)(ai * 128 + m * 16) * ld;
                    float cs[4], sn[4];
#pragma unroll
                    for (int j = 0; j < 4; ++j) { const float a = pos * __builtin_amdgcn_exp2f(-(float)(4 * fq + j) * 0.830482023721841f); cs[j] = __cosf(a); sn[j] = __sinf(a); }
#pragma unroll
                    for (int bj = 0; bj < 2; ++bj) {
                        const f32x4 x1 = acc[ai][bj][m][0], x2 = acc[ai][bj][m][1];
                        u32x2 w1, w2;
                        w1.x = pk2(x1[0] * cs[0] - x2[0] * sn[0], x1[1] * cs[1] - x2[1] * sn[1]); w1.y = pk2(x1[2] * cs[2] - x2[2] * sn[2], x1[3] * cs[3] - x2[3] * sn[3]);
                        w2.x = pk2(x2[0] * cs[0] + x1[0] * sn[0], x2[1] * cs[1] + x1[1] * sn[1]); w2.y = pk2(x2[2] * cs[2] + x1[2] * sn[2], x2[3] * cs[3] + x1[3] * sn[3]);
                        *(u32x2*)(rp + bj * 128) = w1; *(u32x2*)(rp + bj * 128 + 16) = w2;
                    }
                    asm volatile("" ::: "memory");
                }
        } else {
            bf16_t* vp = swvt + ((size_t)b * 256 + cl0) * TT + tokb + rl0;
#pragma unroll
            for (int ai = 0; ai < 2; ++ai)
#pragma unroll
                for (int m = 0; m < 4; ++m) {
#pragma unroll
                    for (int bj = 0; bj < 2; ++bj)
#pragma unroll
                        for (int n = 0; n < 2; ++n) {
                            const f32x4 v = acc[ai][bj][m][n];
#pragma unroll
                            for (int j = 0; j < 4; ++j) vp[(size_t)(bj * 128 + n * 16 + j) * TT + ai * 128 + m * 16] = (bf16_t)f2bf(v[j]);
                        }
                    asm volatile("" ::: "memory");
                }
        }
    }
};

template <class Map>
__device__ __forceinline__ void transpose_item(const float* W, int K, int N, bf16_t* WT, float* scr, int item, int nblk, int lane, Map srccol) {
    const int kb = item / nblk, nb = item % nblk, k0 = 64 * kb, n0 = 32 * nb;
    const int sc = srccol(n0 + (lane & 31));
    float tv[32];
    const float* wp = W + (size_t)(k0 + (lane >> 5)) * N + (sc >= 0 ? sc : 0);
#pragma unroll
    for (int i = 0; i < 32; ++i) tv[i] = wp[(size_t)(2 * i) * N];
#pragma unroll
    for (int i = 0; i < 32; ++i) { const int kk = 2 * i + (lane >> 5); scr[kk * 33 + (lane & 31)] = sc >= 0 ? tv[i] : 0.f; }
    __builtin_amdgcn_s_waitcnt(0); asm volatile("" ::: "memory");
    const int c = lane & 7;
#pragma unroll
    for (int j = 0; j < 4; ++j) { const int n = (lane >> 3) + 8 * j; const float* s = scr + (8 * c) * 33 + n;
        u32x4 o; o.x = pk2(s[0 * 33], s[1 * 33]); o.y = pk2(s[2 * 33], s[3 * 33]); o.z = pk2(s[4 * 33], s[5 * 33]); o.w = pk2(s[6 * 33], s[7 * 33]);
        *(u32x4*)(WT + (size_t)(n0 + n) * K + k0 + 8 * c) = o; }
    __builtin_amdgcn_s_waitcnt(0); asm volatile("" ::: "memory");
}
struct MapId { __device__ int operator()(int n) const { return n; } };
struct MapUp { __device__ int operator()(int c) const { return ((c >> 4) & 1) * DFF + (c >> 8) * 128 + ((c >> 5) & 3) * 32 + ((c >> 2) & 3) * 8 + ((c >> 7) & 1) * 4 + (c & 3); } };
struct MapPad { int lim; __device__ int operator()(int n) const { return n < lim ? n : -1; } };
__device__ __forceinline__ int perm8(int c) { return (c & ~31) + 8 * ((c >> 2) & 3) + 4 * ((c >> 4) & 1) + (c & 3); }
struct MapPerm8 { __device__ int operator()(int c) const { return perm8(c); } };
struct MapEin { __device__ int operator()(int c) const { return c >= 3600 ? -1 : ((c < 1024 || (c >= 1536 && c < 3584)) ? perm8(c) : c); } };

__device__ __forceinline__ int mat_items(int mat) { return mat < 4 ? 16 * 176 : (mat < 8 ? 44 * 32 : (mat == 8 ? 16 * 120 : (mat == 10 ? 16 * 48 : 16 * 32))); }
__device__ __forceinline__ void mat_item(const P& p, float* scr, int mat, int r, int lane) {
    if (mat < 4) transpose_item(p.w_up + (size_t)mat * DM * 2 * DFF, DM, 2 * DFF, (bf16_t*)(p.ws + WS_WUP) + (size_t)mat * 2 * DFF * DM, scr, r, 176, lane, MapUp());
    else if (mat < 8) transpose_item(p.w_dn + (size_t)(mat - 4) * DFF * DM, DFF, DM, (bf16_t*)(p.ws + WS_WDN) + (size_t)(mat - 4) * DM * DFF, scr, r, 32, lane, MapPerm8());
    else if (mat == 8) transpose_item(p.e_in, DM, 3600, (bf16_t*)(p.ws + WS_WEIN), scr, r, 120, lane, MapEin());
    else if (mat == 9) transpose_item(p.e_out, DM, DM, (bf16_t*)(p.ws + WS_WEOUT), scr, r, 32, lane, MapPerm8());
    else if (mat == 10) transpose_item(p.o_in, DM, 1536, (bf16_t*)(p.ws + WS_WOIN), scr, r, 48, lane, MapId());
    else transpose_item(p.o_out, DM, DM, (bf16_t*)(p.ws + WS_WOOUT), scr, r, 32, lane, MapPerm8());
}
__device__ __forceinline__ void run_transposes(const P& p, unsigned char* lds, int wave, int lane, unsigned mask, int wid, int nw) {
    float* scr = (float*)(lds + wave * 8448);
    int base = 0;
#pragma unroll 1
    for (int mat = 0; mat < 12; ++mat) {
        if (!((mask >> mat) & 1u)) continue;
        const int n = mat_items(mat);
        int first = (wid - base % nw + nw) % nw;
#pragma unroll 1
        for (int it = first; it < n; it += nw) mat_item(p, scr, mat, it, lane);
        base += n;
    }
}
__device__ __forceinline__ void ph_prologue(const P& p, unsigned char* lds, int tid, int wave, int lane, int G) {
    run_transposes(p, lds, wave, lane, 0x001u, blockIdx.x * 8 + wave, G * 8);
    __syncthreads();
    float* sv = (float*)lds;
    float* red = (float*)(lds + 36864);
    bool have = false;
    typedef float f32x2_ __attribute__((ext_vector_type(2)));
    for (int task = blockIdx.x; task < 256; task += G) {
        if (!have) {
            for (int i = tid; i < 9 * 1024; i += NTHREADS) { const float v = i < 8192 ? p.c[i] : p.c_ctx[i - 8192]; sv[i] = siluf(v); }
            have = true; __syncthreads();
        }
        const int l = task >> 7, c0 = (task & 127) * 72;
        const bool actv = lane < 36;
        const float* w = p.ada_w + (size_t)l * DM * 9216 + c0 + 2 * (actv ? lane : 0);
        float acc0[9], acc1[9];
#pragma unroll
        for (int r = 0; r < 9; ++r) { acc0[r] = 0.f; acc1[r] = 0.f; }
        const int kb = wave * 128;
#pragma unroll 2
        for (int k4 = 0; k4 < 128; k4 += 4) {
            f32x2_ wv[4];
#pragma unroll
            for (int j = 0; j < 4; ++j) wv[j] = *(const f32x2_*)(w + (size_t)(kb + k4 + j) * 9216);
#pragma unroll
            for (int r = 0; r < 9; ++r) { const f32x4 s4 = *(const f32x4*)(sv + r * 1024 + kb + k4);
                acc0[r] += s4[0] * wv[0].x + s4[1] * wv[1].x + s4[2] * wv[2].x + s4[3] * wv[3].x;
                acc1[r] += s4[0] * wv[0].y + s4[1] * wv[1].y + s4[2] * wv[2].y + s4[3] * wv[3].y; }
        }
        if (actv) {
#pragma unroll
            for (int r = 0; r < 9; ++r) { red[(wave * 9 + r) * 72 + 2 * lane] = acc0[r]; red[(wave * 9 + r) * 72 + 2 * lane + 1] = acc1[r]; }
        }
        __syncthreads();
        for (int i = tid; i < 648; i += NTHREADS) { const int r = i / 72, cc = i % 72; float sum = 0.f;
#pragma unroll
            for (int wv = 0; wv < 8; ++wv) sum += red[(wv * 9 + r) * 72 + cc];
            ((float*)(p.ws + WS_MOD))[((size_t)l * 9 + r) * 9216 + c0 + cc] = sum + p.ada_b[l * 9216 + c0 + cc]; }
        __syncthreads();
    }
}

__device__ __forceinline__ void ph_normmod(const P& p, const float* srclat, const float* srcctx, int rows, int l, int idx, int gw, int ngw, int lane) {
    const float* mod = (const float*)(p.ws + WS_MOD) + (size_t)l * 9 * 9216;
    const float* g = p.norm_g + (l * 3 + idx) * DM;
    bf16_t* A = (bf16_t*)(p.ws + WS_A);
    for (int m = gw; m < rows; m += ngw) {
        const float* src = m < MLAT ? srclat + (size_t)m * DM : srcctx + (size_t)(m - MLAT) * DM;
        const int mr = m < MLAT ? (m >> 11) : 8;
        const float* sh = mod + mr * 9216 + (3 * idx) * DM; const float* sc = sh + DM;
        f32x4 v[4]; float ss = 0.f;
#pragma unroll
        for (int j = 0; j < 4; ++j) { v[j] = *(const f32x4*)(src + 4 * lane + 256 * j); ss += v[j][0] * v[j][0] + v[j][1] * v[j][1] + v[j][2] * v[j][2] + v[j][3] * v[j][3]; }
        const float rstd = 1.0f / sqrtf(wave_sum(ss) * (1.f / DM) + EPS);
#pragma unroll
        for (int j = 0; j < 4; ++j) { const int col = 4 * lane + 256 * j;
            const f32x4 gv = *(const f32x4*)(g + col), shv = *(const f32x4*)(sh + col), scv = *(const f32x4*)(sc + col);
            const f32x4 o = v[j] * rstd * gv * (scv + 1.0f) + shv;
            u32x2 w; w.x = pk2(o[0], o[1]); w.y = pk2(o[2], o[3]); *(u32x2*)(A + (size_t)m * DM + col) = w; }
    }
}
__device__ __forceinline__ void ph_final(const P& p, int gw, int ngw, int lane) {
    for (int m = gw; m < MLAT; m += ngw) {
        float* row = p.out + (size_t)m * DM;
        f32x4 v[4]; float ss = 0.f;
#pragma unroll
        for (int j = 0; j < 4; ++j) { v[j] = *(const f32x4*)(row + 4 * lane + 256 * j); ss += v[j][0] * v[j][0] + v[j][1] * v[j][1] + v[j][2] * v[j][2] + v[j][3] * v[j][3]; }
        const float rstd = 1.0f / sqrtf(wave_sum(ss) * (1.f / DM) + EPS);
#pragma unroll
        for (int j = 0; j < 4; ++j) { const int col = 4 * lane + 256 * j; const f32x4 gv = *(const f32x4*)(p.fin_g + col); *(f32x4*)(row + col) = v[j] * rstd * gv; }
    }
}

#define LDSBAR() do { asm volatile("s_waitcnt lgkmcnt(0)" ::: "memory"); __builtin_amdgcn_s_barrier(); asm volatile("" ::: "memory"); } while (0)
struct AttnState { float m, l; f32x4 o[4]; };
struct AttnKV { bf16x8 a00, a01, a10, a11; s16x4 va[4][2]; float mb[8]; };
struct AttnK { bf16x8 a00, a01, a10, a11; };
struct AttnV { s16x4 va[4][2]; };
__device__ __forceinline__ void attn_load_k(AttnK& k, const bf16_t* k0p, const bf16_t* k1p) {
    k.a00 = *(const bf16x8*)k0p; k.a01 = *(const bf16x8*)(k0p + 32); k.a10 = *(const bf16x8*)k1p; k.a11 = *(const bf16x8*)(k1p + 32);
}
__device__ __forceinline__ void attn_load_v(AttnV& v, const bf16_t* vb, int vds, int v0off, int v1off, int fr) {
#pragma unroll
    for (int dt = 0; dt < 4; ++dt) { const bf16_t* vp = vb + (size_t)(dt * 16 + fr) * vds; v.va[dt][0] = *(const s16x4*)(vp + v0off); v.va[dt][1] = *(const s16x4*)(vp + v1off); }
}
__device__ __forceinline__ void attn_compute_kv(const AttnK& k, const AttnV& v, const float (&mbv)[8], bf16x8 q0, bf16x8 q1, AttnState& st) {
    f32x4 s0 = {0.f, 0.f, 0.f, 0.f}, s1 = {0.f, 0.f, 0.f, 0.f};
    s0 = mfma16(k.a00, q0, s0); s0 = mfma16(k.a01, q1, s0); s1 = mfma16(k.a10, q0, s1); s1 = mfma16(k.a11, q1, s1);
    float sc[8];
#pragma unroll
    for (int r = 0; r < 4; ++r) { sc[r] = s0[r] * 0.125f + mbv[r]; sc[4 + r] = s1[r] * 0.125f + mbv[4 + r]; }
    float mx = sc[0];
#pragma unroll
    for (int i = 1; i < 8; ++i) mx = fmaxf(mx, sc[i]);
    mx = xmax16(xmax32(mx));
    const float mn = fmaxf(st.m, mx), corr = __expf(st.m - mn); st.m = mn;
    float pp[8], ps = 0.f;
#pragma unroll
    for (int i = 0; i < 8; ++i) { pp[i] = __expf(sc[i] - mn); ps += pp[i]; }
    st.l = st.l * corr + ps;
    u32x4 pw; pw.x = pk2(pp[0], pp[1]); pw.y = pk2(pp[2], pp[3]); pw.z = pk2(pp[4], pp[5]); pw.w = pk2(pp[6], pp[7]);
    const bf16x8 pb = __builtin_bit_cast(bf16x8, pw);
#pragma unroll
    for (int dt = 0; dt < 4; ++dt) {
        bf16x8 v8; v8[0] = v.va[dt][0][0]; v8[1] = v.va[dt][0][1]; v8[2] = v.va[dt][0][2]; v8[3] = v.va[dt][0][3]; v8[4] = v.va[dt][1][0]; v8[5] = v.va[dt][1][1]; v8[6] = v.va[dt][1][2]; v8[7] = v.va[dt][1][3];
        st.o[dt] = mfma16(v8, pb, st.o[dt] * corr);
    }
}
template <class F>
__device__ __forceinline__ void attn_load(AttnKV& kv, const bf16_t* k0p, const bf16_t* k1p, const bf16_t* vb, int vds, int v0off, int v1off, F mbf, int fr, int g) {
    kv.a00 = *(const bf16x8*)k0p; kv.a01 = *(const bf16x8*)(k0p + 32); kv.a10 = *(const bf16x8*)k1p; kv.a11 = *(const bf16x8*)(k1p + 32);
#pragma unroll
    for (int dt = 0; dt < 4; ++dt) { const bf16_t* vp = vb + (size_t)(dt * 16 + fr) * vds; kv.va[dt][0] = *(const s16x4*)(vp + v0off); kv.va[dt][1] = *(const s16x4*)(vp + v1off); }
#pragma unroll
    for (int r = 0; r < 4; ++r) { kv.mb[r] = mbf(4 * g + r); kv.mb[4 + r] = mbf(16 + 4 * g + r); }
}
struct AttnKVn { bf16x8 a00, a01, a10, a11; s16x4 va[4][2]; };
struct AttnKn { bf16x8 a00, a01, a10, a11; };
struct AttnVn { s16x4 va[4][2]; };
struct AttnKVref { const AttnKn& k; const AttnVn& v; };
__device__ __forceinline__ void attn_load_n(AttnKVn& kv, const bf16_t* k0p, const bf16_t* k1p, const bf16_t* vb, int vds, int v0off, int v1off, int fr) {
    kv.a00 = *(const bf16x8*)k0p; kv.a01 = *(const bf16x8*)(k0p + 32); kv.a10 = *(const bf16x8*)k1p; kv.a11 = *(const bf16x8*)(k1p + 32);
#pragma unroll
    for (int dt = 0; dt < 4; ++dt) { const bf16_t* vp = vb + (size_t)(dt * 16 + fr) * vds; kv.va[dt][0] = *(const s16x4*)(vp + v0off); kv.va[dt][1] = *(const s16x4*)(vp + v1off); }
}
template <class KV>
__device__ __forceinline__ void attn_compute(const KV& kv, const float (&mbv)[8], bf16x8 q0, bf16x8 q1, AttnState& st) {
    f32x4 s0 = {0.f, 0.f, 0.f, 0.f}, s1 = {0.f, 0.f, 0.f, 0.f};
    s0 = mfma16(kv.a00, q0, s0); s0 = mfma16(kv.a01, q1, s0); s1 = mfma16(kv.a10, q0, s1); s1 = mfma16(kv.a11, q1, s1);
    float sc[8];
#pragma unroll
    for (int r = 0; r < 4; ++r) { sc[r] = s0[r] * 0.125f + mbv[r]; sc[4 + r] = s1[r] * 0.125f + mbv[4 + r]; }
    float mx = sc[0];
#pragma unroll
    for (int i = 1; i < 8; ++i) mx = fmaxf(mx, sc[i]);
    mx = xmax16(xmax32(mx));
    const float mn = fmaxf(st.m, mx), corr = __expf(st.m - mn); st.m = mn;
    float pp[8], ps = 0.f;
#pragma unroll
    for (int i = 0; i < 8; ++i) { pp[i] = __expf(sc[i] - mn); ps += pp[i]; }
    st.l = st.l * corr + ps;
    u32x4 pw; pw.x = pk2(pp[0], pp[1]); pw.y = pk2(pp[2], pp[3]); pw.z = pk2(pp[4], pp[5]); pw.w = pk2(pp[6], pp[7]);
    const bf16x8 pb = __builtin_bit_cast(bf16x8, pw);
#pragma unroll
    for (int dt = 0; dt < 4; ++dt) {
        bf16x8 v8; v8[0] = kv.va[dt][0][0]; v8[1] = kv.va[dt][0][1]; v8[2] = kv.va[dt][0][2]; v8[3] = kv.va[dt][0][3]; v8[4] = kv.va[dt][1][0]; v8[5] = kv.va[dt][1][1]; v8[6] = kv.va[dt][1][2]; v8[7] = kv.va[dt][1][3];
        st.o[dt] = mfma16(v8, pb, st.o[dt] * corr);
    }
}
template <int NCH, class LD, class CP>
__device__ __forceinline__ void attn_run(LD ld, CP cp) {
    AttnKV A, B; ld(0, A);
    int i = 0;
#pragma unroll 1
    for (; i + 1 < NCH; i += 2) {
        ld(i + 1, B);
        cp(i, A);
        ld(i + 2 < NCH ? i + 2 : NCH - 1, A);
        cp(i + 1, B);
    }
    if (NCH & 1) cp(NCH - 1, A);
}
__device__ __forceinline__ void attn_finish(AttnState& st, bf16_t* yrow  , int g) {
    float l = st.l; l += __shfl_xor(l, 16); l += __shfl_xor(l, 32);
    const float inv = 1.0f / l;
#pragma unroll
    for (int dt = 0; dt < 4; ++dt) { const f32x4 o = st.o[dt] * inv; u32x2 w; w.x = pk2(o[0], o[1]); w.y = pk2(o[2], o[3]); *(u32x2*)(yrow + dt * 16 + 4 * g) = w; }
}
__device__ __forceinline__ int clampi(int v, int lo, int hi) { return v < lo ? lo : (v > hi ? hi : v); }

__device__ __forceinline__ void na_task(const P& p, int task, int lane, float* ldsw  ) {
    const int fr = lane & 15, g = lane >> 4;
    const bf16_t* QK = (const bf16_t*)(p.ws + WS_NAQK); const bf16_t* VT = (const bf16_t*)(p.ws + WS_NAVT); bf16_t* Y = (bf16_t*)(p.ws + WS_A);
    if (task < 2048) {
        const int h = task & 7, r = (task >> 3) & 31, b = task >> 8;
        for (int i = lane; i < 465; i += 64) ldsw[i] = p.rpb[h * 465 + i];
        AttnState st[4];
        bf16_t* qlds = (bf16_t*)(ldsw + 512) + fr * 72 + g * 8;
        const size_t qrow0 = (size_t)b * TLAT + r * 64 + fr;
#pragma unroll
        for (int j = 0; j < 4; ++j) {
            st[j].m = -1e30f; st[j].l = 0.f;
#pragma unroll
            for (int dt = 0; dt < 4; ++dt) st[j].o[dt] = (f32x4){0.f, 0.f, 0.f, 0.f};
            const bf16_t* qp = QK + (qrow0 + j * 16) * 1024 + h * 64 + g * 8;
            *(bf16x8*)(qlds + j * 16 * 72) = *(const bf16x8*)qp; *(bf16x8*)(qlds + j * 16 * 72 + 32) = *(const bf16x8*)(qp + 32);
        }
        const int r0 = clampi(r - 4, 0, 24);
        const bf16_t* vb = VT + ((size_t)b * 512 + h * 64) * TT;
        const bf16_t* kbase = QK + 512 + h * 64 + g * 8;
        auto ldk = [&](int i, AttnKn& k) {
            const bf16_t* k0p = (i < 16) ? kbase + ((size_t)b * TLAT + (r0 + (i >> 1)) * 64 + (i & 1) * 32 + fr) * 1024 : kbase + ((size_t)MLAT + b * TCTX + (i - 16) * 32 + fr) * 1024;
            k.a00 = *(const bf16x8*)k0p; k.a01 = *(const bf16x8*)(k0p + 32); k.a10 = *(const bf16x8*)(k0p + 16 * 1024); k.a11 = *(const bf16x8*)(k0p + 16 * 1024 + 32);
        };
        auto ldv = [&](int i, AttnVn& v) {
            const int tok0 = (i < 16) ? (r0 + (i >> 1)) * 64 + (i & 1) * 32 : TLAT + (i - 16) * 32;
#pragma unroll
            for (int dt = 0; dt < 4; ++dt) { const bf16_t* vp = vb + (size_t)(dt * 16 + fr) * TT + tok0 + 4 * g; v.va[dt][0] = *(const s16x4*)vp; v.va[dt][1] = *(const s16x4*)(vp + 16); }
        };
        asm volatile("s_waitcnt lgkmcnt(0)" ::: "memory");
        AttnKn kc, kn; AttnVn vv; ldk(0, kc);
#pragma unroll 1
        for (int i = 0; i < 24; ++i) {
            ldk(i + 1 < 24 ? i + 1 : i, kn);
            ldv(i, vv);
            const int half = i & 1;
            const float* rp = ldsw + (r0 + (i >> 1) - r + 7) * 31;
#pragma unroll
            for (int j = 0; j < 4; ++j) {
                if (i < 16 && (half ? j == 0 : j == 3)) continue;
                float mbv[8];
                if (i < 16) {
                    const int qcol = j * 16 + fr, cst = clampi(qcol - 8, 0, 48);
#pragma unroll
                    for (int q8 = 0; q8 < 8; ++q8) { const int kk = (q8 < 4) ? 4 * g + q8 : 12 + 4 * g + q8; const int kcc = half * 32 + kk;
                        const bool ok = (kcc >= cst) && (kcc < cst + 16); const float bv = rp[clampi(kcc - qcol + 15, 0, 30)]; mbv[q8] = ok ? bv : -2e30f; }
                } else {
#pragma unroll
                    for (int q8 = 0; q8 < 8; ++q8) mbv[q8] = 0.f;
                }
                AttnKVn tmp; tmp.a00 = kc.a00; tmp.a01 = kc.a01; tmp.a10 = kc.a10; tmp.a11 = kc.a11;
#pragma unroll
                for (int dt = 0; dt < 4; ++dt) { tmp.va[dt][0] = vv.va[dt][0]; tmp.va[dt][1] = vv.va[dt][1]; }
                attn_compute(tmp, mbv, *(const bf16x8*)(qlds + j * 16 * 72), *(const bf16x8*)(qlds + j * 16 * 72 + 32), st[j]);
                __builtin_amdgcn_sched_barrier(0);
            }
            kc = kn;
        }
#pragma unroll
        for (int j = 0; j < 4; ++j) attn_finish(st[j], Y + (qrow0 + j * 16) * 1024 + h * 64, g);
    } else {
        AttnState st; st.m = -1e30f; st.l = 0.f;
#pragma unroll
        for (int dt = 0; dt < 4; ++dt) st.o[dt] = (f32x4){0.f, 0.f, 0.f, 0.f};
        const int t2 = task - 2048; const int h = t2 & 7, qb = (t2 >> 3) & 15, b = t2 >> 7;
        const size_t qrow = (size_t)MLAT + b * TCTX + qb * 16 + fr;
        const bf16_t* qp = QK + qrow * 1024 + h * 64 + g * 8;
        const bf16x8 q0 = *(const bf16x8*)qp, q1 = *(const bf16x8*)(qp + 32);
        const bf16_t* vb = VT + ((size_t)b * 512 + h * 64) * TT;
        const bf16_t* kbase = QK + 512 + h * 64 + g * 8;
        auto ld = [&](int c, AttnKV& kv) {
            const bf16_t* k0p = kbase + ((size_t)MLAT + b * TCTX + c * 32 + fr) * 1024;
            auto mb = [&](int) -> float { return 0.f; };
            attn_load(kv, k0p, k0p + 16 * 1024, vb, TT, TLAT + c * 32 + 4 * g, TLAT + c * 32 + 16 + 4 * g, mb, fr, g);
        };
        attn_run<8>(ld, [&](int, const AttnKV& kv) { attn_compute(kv, kv.mb, q0, q1, st); });
        attn_finish(st, Y + qrow * 1024 + h * 64, g);
    }
}
__device__ __forceinline__ void swa_task(const P& p, int task, int lane) {
    const int fr = lane & 15, g = lane >> 4;
    const bf16_t* Q = (const bf16_t*)(p.ws + WS_SWQ); const bf16_t* K = (const bf16_t*)(p.ws + WS_SWK); const bf16_t* VT = (const bf16_t*)(p.ws + WS_SWVT); bf16_t* Y = (bf16_t*)(p.ws + WS_A);
    const int g4 = task & 3, qb = (task >> 2) & 127, b = task >> 9;
    const int qt = qb * 16 + fr; const size_t qrow = (size_t)b * TLAT + qt;
    AttnState st[4]; bf16x8 q0[4], q1[4];
#pragma unroll
    for (int hh = 0; hh < 4; ++hh) {
        const int hq = g4 * 4 + hh;
        st[hh].m = p.sink[hq]; st[hh].l = (g == 0) ? 1.f : 0.f;
#pragma unroll
        for (int dt = 0; dt < 4; ++dt) st[hh].o[dt] = (f32x4){0.f, 0.f, 0.f, 0.f};
        const bf16_t* qp = Q + qrow * 1024 + hq * 64 + g * 8;
        q0[hh] = *(const bf16x8*)qp; q1[hh] = *(const bf16x8*)(qp + 32);
    }
    const bf16_t* vb = VT + ((size_t)b * 256 + g4 * 64) * TT;
    const bf16_t* kbase = K + g4 * 64 + g * 8;
    auto ld = [&](int i, AttnKV& kv) {
        if (i < 9) {
            const int kt0 = qb * 16 - 128 + 32 * i;
            const int kr0 = clampi(kt0 + fr, 0, TLAT - 1), kr1 = clampi(kt0 + 16 + fr, 0, TLAT - 1);
            const int v0 = clampi(kt0 + 4 * g, 0, TLAT - 4), v1 = clampi(kt0 + 16 + 4 * g, 0, TLAT - 4);
            auto mb = [&](int) -> float { return 0.f; };
            attn_load(kv, kbase + ((size_t)b * TLAT + kr0) * 256, kbase + ((size_t)b * TLAT + kr1) * 256, vb, TT, v0, v1, mb, fr, g);
        } else {
            const int c = i - 9;
            const bf16_t* k0p = kbase + ((size_t)MLAT + b * TCTX + c * 32 + fr) * 256;
            auto mb = [&](int) -> float { return 0.f; };
            attn_load(kv, k0p, k0p + 16 * 256, vb, TT, TLAT + c * 32 + 4 * g, TLAT + c * 32 + 16 + 4 * g, mb, fr, g);
        }
    };
    {
        AttnKV cur, nxt; ld(0, cur);
#pragma unroll 1
        for (int i = 0; i < 17; ++i) {
            const int in = (i + 1 < 17) ? i + 1 : i;
            ld(in, nxt);
            float mbv[8];
            {
                const int kt0 = qb * 16 - 128 + 32 * i;
#pragma unroll
                for (int r = 0; r < 8; ++r) { const int kk = (r < 4) ? 4 * g + r : 12 + 4 * g + r; const int kt = kt0 + kk; const int d = kt - qt;
                    const bool ok = (i >= 9) || ((kt >= 0) && (kt < TLAT) && (d <= 128) && (d >= -128)); mbv[r] = ok ? 0.f : -1e30f; }
            }
#pragma unroll
            for (int hh = 0; hh < 4; ++hh) attn_compute(cur, mbv, q0[hh], q1[hh], st[hh]);
            cur = nxt;
        }
    }
#pragma unroll
    for (int hh = 0; hh < 4; ++hh) attn_finish(st[hh], Y + qrow * 1024 + (g4 * 4 + hh) * 64, g);
}

constexpr int SW_KB = 4608, SW_STAGE = 4608 + 5120;
__device__ __forceinline__ void swa_block_task(const P& p, int task, unsigned char* sm, int tid) {
    const int wave = tid >> 6, lane = tid & 63, fr = lane & 15, g = lane >> 4;
    const bf16_t* Q = (const bf16_t*)(p.ws + WS_SWQ); const bf16_t* K = (const bf16_t*)(p.ws + WS_SWK); const bf16_t* VT = (const bf16_t*)(p.ws + WS_SWVT); bf16_t* Y = (bf16_t*)(p.ws + WS_A);
    const int g4 = task & 3, qblk = (task >> 2) & 15, b = task >> 6;
    const int Q0 = qblk * 128, qt = Q0 + wave * 16 + fr; const size_t qrow = (size_t)b * TLAT + qt;
    AttnState st[4]; bf16x8 q0[4], q1[4];
#pragma unroll
    for (int hh = 0; hh < 4; ++hh) {
        const int hq = g4 * 4 + hh;
        st[hh].m = p.sink[hq]; st[hh].l = (g == 0) ? 1.f : 0.f;
#pragma unroll
        for (int dt = 0; dt < 4; ++dt) st[hh].o[dt] = (f32x4){0.f, 0.f, 0.f, 0.f};
        const bf16_t* qp = Q + qrow * 1024 + hq * 64 + g * 8;
        q0[hh] = *(const bf16x8*)qp; q1[hh] = *(const bf16x8*)(qp + 32);
    }
    const int cw0 = Q0 >= 128 ? 0 : (128 - Q0) / 32, cw1 = (Q0 + 256 <= TLAT) ? 11 : (TLAT - 1 - (Q0 - 128)) / 32;
    const int nwin = cw1 - cw0 + 1, nch = nwin + 8;
    const bool isk = tid < 256; const int lr = isk ? (tid >> 3) : ((tid - 256) >> 2), lp = isk ? (tid & 7) : (tid & 3);
    auto gload = [&](int i) -> u32x4 {
        const int tok0 = (i < nwin) ? (Q0 - 128 + 32 * (cw0 + i)) : (TLAT + 32 * (i - nwin));
        if (isk) { const size_t row = (i < nwin) ? (size_t)b * TLAT + tok0 + lr : (size_t)MLAT + b * TCTX + 32 * (i - nwin) + lr;
            return *(const u32x4*)(K + row * 256 + g4 * 64 + lp * 8); }
        return *(const u32x4*)(VT + ((size_t)b * 256 + g4 * 64 + lr) * TT + tok0 + lp * 8);
    };
    auto lwrite = [&](int stage, const u32x4& v) {
        unsigned char* sb = sm + stage * SW_STAGE;
        if (isk) *(u32x4*)(sb + lr * 144 + lp * 16) = v; else *(u32x4*)(sb + SW_KB + lr * 80 + lp * 16) = v;
    };
    u32x4 R = gload(0);
    lwrite(0, R);
    if (nch > 1) R = gload(1);
    LDSBAR();
#pragma unroll 1
    for (int i = 0; i < nch; ++i) {
        const unsigned char* sb = sm + (i & 1) * SW_STAGE;
        const bool win = i < nwin;
        const int kt0 = Q0 - 128 + 32 * (cw0 + i);
        const int qt0 = Q0 + wave * 16;
        const bool need = !win || (kt0 + 31 >= qt0 - 128 && kt0 <= qt0 + 15 + 128);
        if (need) {
            AttnKVn kv;
            { const unsigned char* kp = sb + fr * 144 + g * 16;
              kv.a00 = *(const bf16x8*)kp; kv.a01 = *(const bf16x8*)(kp + 64); kv.a10 = *(const bf16x8*)(kp + 16 * 144); kv.a11 = *(const bf16x8*)(kp + 16 * 144 + 64);
#pragma unroll
              for (int dt = 0; dt < 4; ++dt) { const unsigned char* vp = sb + SW_KB + (dt * 16 + fr) * 80 + g * 8; kv.va[dt][0] = *(const s16x4*)vp; kv.va[dt][1] = *(const s16x4*)(vp + 32); } }
            float mbv[8];
#pragma unroll
            for (int r = 0; r < 8; ++r) { const int kk = (r < 4) ? 4 * g + r : 12 + 4 * g + r; const int d = kt0 + kk - qt; mbv[r] = (!win || (d <= 128 && d >= -128)) ? 0.f : -1e30f; }
#pragma unroll
            for (int hh = 0; hh < 4; ++hh) attn_compute(kv, mbv, q0[hh], q1[hh], st[hh]);
        }
        if (i + 1 < nch) lwrite((i + 1) & 1, R);
        if (i + 2 < nch) R = gload(i + 2);
        LDSBAR();
    }
#pragma unroll
    for (int hh = 0; hh < 4; ++hh) attn_finish(st[hh], Y + qrow * 1024 + (g4 * 4 + hh) * 64, g);
}

__device__ __forceinline__ void dn_conv_token4(const P& p, int m0, int lane) {
    const bf16_t* PRE = (const bf16_t*)(p.ws + WS_DNPRE);
    int s0, s1;
    if (m0 < MLAT) { s0 = m0 & ~2047; s1 = s0 + 2048; } else { s0 = MLAT + ((m0 - MLAT) & ~255); s1 = s0 + 256; }
#pragma unroll 1
    for (int cgp = 0; cgp < 3; ++cgp) {
        const int col = cgp * 512 + lane * 8;
        f32x4 w[5][2];
#pragma unroll
        for (int j = 0; j < 5; ++j) { w[j][0] = *(const f32x4*)(p.conv_w + j * 1536 + col); w[j][1] = *(const f32x4*)(p.conv_w + j * 1536 + col + 4); }
        u32x4 xr[8];
#pragma unroll
        for (int r = 0; r < 8; ++r) { const int mm = m0 + r - 2; xr[r] = (mm >= s0 && mm < s1) ? *(const u32x4*)(PRE + (size_t)mm * 1536 + col) : (u32x4){0u, 0u, 0u, 0u}; }
        bf16_t* dbase = (bf16_t*)(p.ws + (cgp == 0 ? WS_QN : (cgp == 1 ? WS_KN : WS_VV))) + lane * 8;
#pragma unroll
        for (int t = 0; t < 4; ++t) {
            float acc[8];
#pragma unroll
            for (int i = 0; i < 8; ++i) acc[i] = 0.f;
#pragma unroll
            for (int j = 0; j < 5; ++j) { const u32x4 xv = xr[t + j];
                acc[0] += bflo(xv.x) * w[j][0][0]; acc[1] += bfhi(xv.x) * w[j][0][1]; acc[2] += bflo(xv.y) * w[j][0][2]; acc[3] += bfhi(xv.y) * w[j][0][3];
                acc[4] += bflo(xv.z) * w[j][1][0]; acc[5] += bfhi(xv.z) * w[j][1][1]; acc[6] += bflo(xv.w) * w[j][1][2]; acc[7] += bfhi(xv.w) * w[j][1][3]; }
            float ss = 0.f;
#pragma unroll
            for (int i = 0; i < 8; ++i) { acc[i] = siluf(acc[i]); ss += acc[i] * acc[i]; }
            if (cgp < 2) {
                ss += __shfl_xor(ss, 1); ss += __shfl_xor(ss, 2); ss += __shfl_xor(ss, 4); ss += __shfl_xor(ss, 8);
                const float rn = 1.0f / sqrtf(ss + EPS);
#pragma unroll
                for (int i = 0; i < 8; ++i) acc[i] *= rn;
            }
            u32x4 o; o.x = pk2(acc[0], acc[1]); o.y = pk2(acc[2], acc[3]); o.z = pk2(acc[4], acc[5]); o.w = pk2(acc[6], acc[7]);
            *(u32x4*)(dbase + (size_t)(m0 + t) * 512) = o;
        }
    }
    {
        const int m = m0 + (lane >> 4), idx = lane & 15;
        const float a = ((const float*)(p.ws + WS_AB))[(size_t)m * 16 + idx];
        float r;
        if (idx < 8) { const float xx = a + p.dt_bias[idx]; const float sp = fmaxf(xx, 0.f) + log1pf(__expf(-fabsf(xx))); r = -__expf(p.a_log[idx]) * sp; }
        else r = 1.f / (1.f + __expf(-a));
        ((float*)(p.ws + WS_GB))[(size_t)m * 16 + idx] = r;
    }
}

template <int DIR>
__device__ __forceinline__ void dn_solve(const P& p, int task, int m0, int h, int t2, const bf16_t* kn_s, const bf16_t* v_s, const float* gc, const float* be, float* L) {
    float x[64];
    if (t2 < 128) {
#pragma unroll
        for (int cp = 0; cp < 64; ++cp) { const int tok = DIR ? 63 - cp : cp; x[cp] = bf2f(v_s[tok * 136 + t2]) * be[cp]; }
    } else {
        const int k = t2 - 128;
#pragma unroll
        for (int cp = 0; cp < 64; ++cp) { const int tok = DIR ? 63 - cp : cp; x[cp] = bf2f(kn_s[tok * 136 + k]) * be[cp] * __expf(gc[cp]); }
    }
#pragma unroll
    for (int cp = 1; cp < 64; ++cp) {
        float a0 = 0.f, a1 = 0.f, a2 = 0.f, a3 = 0.f;
#pragma unroll
        for (int s4 = 0; s4 < cp; s4 += 4) { const f32x4 l4 = *(const f32x4*)(L + cp * 64 + s4); a0 += l4[0] * x[s4]; a1 += l4[1] * x[s4 + 1]; a2 += l4[2] * x[s4 + 2]; a3 += l4[3] * x[s4 + 3]; }
        x[cp] -= (a0 + a1) + (a2 + a3);
    }
    const size_t dt = (size_t)task * 2 + DIR;
    if (t2 < 128) {
        bf16_t* dst = (bf16_t*)(p.ws + WS_UT) + dt * 8192 + t2 * 64;
#pragma unroll
        for (int t8 = 0; t8 < 64; t8 += 8) {
            u32x4 o;
            o.x = pk2(x[DIR ? 63 - t8 : t8], x[DIR ? 62 - t8 : t8 + 1]); o.y = pk2(x[DIR ? 61 - t8 : t8 + 2], x[DIR ? 60 - t8 : t8 + 3]);
            o.z = pk2(x[DIR ? 59 - t8 : t8 + 4], x[DIR ? 58 - t8 : t8 + 5]); o.w = pk2(x[DIR ? 57 - t8 : t8 + 6], x[DIR ? 56 - t8 : t8 + 7]);
            *(u32x4*)(dst + t8) = o;
        }
    }
    __syncthreads();
    bf16_t* wt = (bf16_t*)L;
    if (t2 >= 128) {
        const int k = t2 - 128;
#pragma unroll
        for (int cp = 0; cp < 64; ++cp) { const int tok = DIR ? 63 - cp : cp; wt[tok * 128 + k] = (bf16_t)f2bf(-x[cp]); }
    }
    __syncthreads();
    {
        u32x4* dst = (u32x4*)((bf16_t*)(p.ws + WS_NEGW) + dt * 8192);
#pragma unroll
        for (int i = 0; i < 4; ++i) dst[t2 + 256 * i] = *(const u32x4*)(wt + (t2 + 256 * i) * 8);
    }
}

__device__ __forceinline__ void dn_prep_task(const P& p, int task, unsigned char* sm, int tid) {
    const int h = task & 3, bc = task >> 2, ck = bc % 36, b = bc / 36;
    const int m0 = ck < 4 ? MLAT + b * TCTX + ck * 64 : b * TLAT + (ck - 4) * 64;
    const int wave = tid >> 6, lane = tid & 63, dir = tid >> 8, t2 = tid & 255;
    bf16_t* kn_s = (bf16_t*)sm;
    bf16_t* qn_s = kn_s + 64 * 136;
    float* KK = (float*)(sm + 34816);
    float* QK = KK + 64 * 65;
    float* gc_s = (float*)(sm + 68096);
    float* be_s = gc_s + 128;
    float* Ls = be_s + 128;
    bf16_t* v_s = (bf16_t*)(sm + 101888);
    {
        const int r = tid >> 3, c16 = (tid & 7) * 16;
        const bf16_t* ks = (const bf16_t*)(p.ws + WS_KN) + (size_t)(m0 + r) * 512 + h * 128 + c16;
        const bf16_t* qs = (const bf16_t*)(p.ws + WS_QN) + (size_t)(m0 + r) * 512 + h * 128 + c16;
        *(u32x4*)(kn_s + r * 136 + c16) = *(const u32x4*)ks; *(u32x4*)(kn_s + r * 136 + c16 + 8) = *(const u32x4*)(ks + 8);
        *(u32x4*)(qn_s + r * 136 + c16) = *(const u32x4*)qs; *(u32x4*)(qn_s + r * 136 + c16 + 8) = *(const u32x4*)(qs + 8);
        const bf16_t* vs = (const bf16_t*)(p.ws + WS_VV) + (size_t)(m0 + r) * 512 + h * 128 + c16;
        *(u32x4*)(v_s + r * 136 + c16) = *(const u32x4*)vs; *(u32x4*)(v_s + r * 136 + c16 + 8) = *(const u32x4*)(vs + 8);
    }
    if (t2 < 64) {
        const int tok = dir ? 63 - t2 : t2;
        const float* gb = (const float*)(p.ws + WS_GB) + (size_t)(m0 + tok) * 16;
        float gv = gb[dir * 4 + h]; const float bv = gb[8 + dir * 4 + h];
#pragma unroll
        for (int o = 1; o < 64; o <<= 1) { const float v = __shfl_up(gv, o); if (lane >= o) gv += v; }
        gc_s[dir * 64 + t2] = gv; be_s[dir * 64 + t2] = bv;
    }
    __syncthreads();
    {
        const int which = wave >> 2, it = wave & 3, fr = lane & 15, g = lane >> 4;
        const bf16_t* As = which ? qn_s : kn_s; float* Out = which ? QK : KK;
        bf16x8 a[4];
#pragma unroll
        for (int ks = 0; ks < 4; ++ks) a[ks] = *(const bf16x8*)(As + (it * 16 + fr) * 136 + ks * 32 + g * 8);
#pragma unroll
        for (int jt = 0; jt < 4; ++jt) {
            f32x4 acc = {0.f, 0.f, 0.f, 0.f};
#pragma unroll
            for (int ks = 0; ks < 4; ++ks) { const bf16x8 bb = *(const bf16x8*)(kn_s + (jt * 16 + fr) * 136 + ks * 32 + g * 8); acc = mfma16(a[ks], bb, acc); }
#pragma unroll
            for (int r = 0; r < 4; ++r) Out[(it * 16 + 4 * g + r) * 65 + jt * 16 + fr] = acc[r];
        }
    }
    __syncthreads();
    const float* gc = gc_s + dir * 64; const float* be = be_s + dir * 64; float* L = Ls + dir * 4096;
    const size_t dt = (size_t)task * 2 + dir;
    {
        const int cp = t2 >> 2, s0 = (t2 & 3) * 16; const int ctok = dir ? 63 - cp : cp; const float gcc = gc[cp], bec = be[cp];
#pragma unroll
        for (int i = 0; i < 16; ++i) { const int sp = s0 + i, stok = dir ? 63 - sp : sp; float v = 0.f; if (cp > sp) v = bec * KK[ctok * 65 + stok] * __expf(gcc - gc[sp]); L[cp * 64 + sp] = v; }
        const int c = t2 >> 2, c_p = dir ? 63 - c : c; const float gq = gc[c_p];
        float qv[16];
#pragma unroll
        for (int i = 0; i < 16; ++i) { const int s = s0 + i, s_p = dir ? 63 - s : s; qv[i] = (c_p >= s_p) ? QK[c * 65 + s] * SCALE_DK * __expf(gq - gc[s_p]) : 0.f; }
        bf16_t* qd = (bf16_t*)(p.ws + WS_QKC) + dt * 4096 + c * 64 + s0;
        u32x4 o0, o1; o0.x = pk2(qv[0], qv[1]); o0.y = pk2(qv[2], qv[3]); o0.z = pk2(qv[4], qv[5]); o0.w = pk2(qv[6], qv[7]);
        o1.x = pk2(qv[8], qv[9]); o1.y = pk2(qv[10], qv[11]); o1.z = pk2(qv[12], qv[13]); o1.w = pk2(qv[14], qv[15]);
        *(u32x4*)qd = o0; *(u32x4*)(qd + 8) = o1;
        if (t2 < 64) { const int cc = t2, ccp = dir ? 63 - cc : cc; float* rs = (float*)(p.ws + WS_RSCS) + dt * 256;
            rs[cc] = SCALE_DK * __expf(gc[ccp]); rs[64 + cc] = __expf(gc[63] - gc[ccp]); if (t2 == 0) rs[128] = __expf(gc[63]); }
    }
    {
        const int k = tid >> 2, tk0 = (tid & 3) * 16; float kv[16];
#pragma unroll
        for (int i = 0; i < 16; ++i) kv[i] = bf2f(kn_s[(tk0 + i) * 136 + k]);
        bf16_t* kd = (bf16_t*)(p.ws + WS_KNT) + (size_t)task * 8192 + k * 64 + tk0;
        u32x4 o0, o1; o0.x = pk2(kv[0], kv[1]); o0.y = pk2(kv[2], kv[3]); o0.z = pk2(kv[4], kv[5]); o0.w = pk2(kv[6], kv[7]);
        o1.x = pk2(kv[8], kv[9]); o1.y = pk2(kv[10], kv[11]); o1.z = pk2(kv[12], kv[13]); o1.w = pk2(kv[14], kv[15]);
        *(u32x4*)kd = o0; *(u32x4*)(kd + 8) = o1;
    }
    __syncthreads();
    if (dir == 0) dn_solve<0>(p, task, m0, h, t2, kn_s, v_s, gc, be, L); else dn_solve<1>(p, task, m0, h, t2, kn_s, v_s, gc, be, L);
    __syncthreads();
}

struct ScanRegs { u32x4 a[2], b[2], c, d[2], e, f; };
constexpr int SC_QN = 17408, SC_QK = 34816, SC_KNT = 44032, SC_UT = 62464, SC_RS = 67072, SC_STAGE = 67648, SC_BASE = 18432;
__device__ __forceinline__ int scan_m0(int step, int b, int dir, int& task_out, int h) {
    const int ck = dir ? (step < 4 ? 3 - step : 39 - step) : step;
    task_out = (b * 36 + ck) * 4 + h;
    return ck < 4 ? MLAT + b * TCTX + ck * 64 : b * TLAT + (ck - 4) * 64;
}
__device__ __forceinline__ void scan_gload(ScanRegs& R, const P& p, int step, int b, int h, int dir, int es, int t) {
    int task; const int m0 = scan_m0(step, b, dir, task, h); const size_t dt = (size_t)task * 2 + dir;
    const u32x4* negw = (const u32x4*)((const bf16_t*)(p.ws + WS_NEGW) + dt * 8192);
    const u32x4* qk = (const u32x4*)((const bf16_t*)(p.ws + WS_QKC) + dt * 4096);
    const u32x4* knT = (const u32x4*)((const bf16_t*)(p.ws + WS_KNT) + (size_t)task * 8192);
    const u32x4* uT = (const u32x4*)((const bf16_t*)(p.ws + WS_UT) + dt * 8192 + es * 32 * 64);
    const u32x4* rscs = (const u32x4*)((const float*)(p.ws + WS_RSCS) + dt * 256);
    const bf16_t* qn = (const bf16_t*)(p.ws + WS_QN) + (size_t)m0 * 512 + h * 128;
#pragma unroll
    for (int i = 0; i < 2; ++i) { const int pp = t + 512 * i; R.a[i] = negw[pp]; R.b[i] = *(const u32x4*)(qn + (size_t)(pp >> 4) * 512 + (pp & 15) * 8); R.d[i] = knT[pp]; }
    R.c = qk[t];
    R.e = uT[t & 255];
    R.f = rscs[t < 33 ? t : 0];
}
__device__ __forceinline__ void scan_lwrite(unsigned char* sb, const ScanRegs& R, int t) {
#pragma unroll
    for (int i = 0; i < 2; ++i) { const int pp = t + 512 * i;
        *(u32x4*)(sb + (pp >> 4) * 272 + (pp & 15) * 16) = R.a[i];
        *(u32x4*)(sb + SC_QN + (pp >> 4) * 272 + (pp & 15) * 16) = R.b[i];
        *(u32x4*)(sb + SC_KNT + (pp >> 3) * 144 + (pp & 7) * 16) = R.d[i]; }
    *(u32x4*)(sb + SC_QK + (t >> 3) * 144 + (t & 7) * 16) = R.c;
    if (t < 256) *(u32x4*)(sb + SC_UT + (t >> 3) * 144 + (t & 7) * 16) = R.e;
    if (t < 33) *(u32x4*)(sb + SC_RS + t * 16) = R.f;
}
__device__ __forceinline__ void dn_scan_task(const P& p, int st, unsigned char* sm, int tid) {
    const int combo = (st & 7) + 8 * (st >> 5), es = (st >> 3) & 3;
    const int dir = combo & 1, h = (combo >> 1) & 3, b = combo >> 3;
    const int wave = tid >> 6, lane = tid & 63, fr = lane & 15, g = lane >> 4;
    bf16_t* ST = (bf16_t*)sm;
    bf16_t* VT = ST + 32 * 136;
    bf16_t* VS = VT + 32 * 72;
    const int ct = wave & 3, en = wave >> 2, e0 = es * 32 + en * 16, kt0 = 2 * (wave & 3);
    f32x4 S0 = {0.f, 0.f, 0.f, 0.f}, S1 = {0.f, 0.f, 0.f, 0.f};
    for (int i = tid; i < 32 * 136 / 2; i += NTHREADS) ((unsigned*)ST)[i] = 0u;
    float* O = (float*)(p.ws + (dir ? WS_KN : WS_O));
    ScanRegs R;
    scan_gload(R, p, 0, b, h, dir, es, tid);
    scan_lwrite(sm + SC_BASE, R, tid);
    scan_gload(R, p, 1, b, h, dir, es, tid);
    LDSBAR();
#pragma unroll 1
    for (int step = 0; step < 36; ++step) {
        const unsigned char* sb = sm + SC_BASE + (step & 1) * SC_STAGE;
        int task_; const int m0 = scan_m0(step, b, dir, task_, h);
        f32x4 vn, oq = {0.f, 0.f, 0.f, 0.f};
        { const s16x4 u4 = *(const s16x4*)(sb + SC_UT + (en * 16 + fr) * 144 + (ct * 16 + 4 * g) * 2);
#pragma unroll
          for (int r = 0; r < 4; ++r) vn[r] = bf2f((unsigned short)u4[r]); }
        const f32x4 rs = *(const f32x4*)(sb + SC_RS + (ct * 16 + 4 * g) * 4), cs = *(const f32x4*)(sb + SC_RS + 256 + (ct * 16 + 4 * g) * 4);
        const float gl = *(const float*)(sb + SC_RS + 512);
#pragma unroll
        for (int ks = 0; ks < 4; ++ks) {
            const bf16x8 bs = *(const bf16x8*)(ST + (en * 16 + fr) * 136 + ks * 32 + g * 8);
            const bf16x8 aw = *(const bf16x8*)(sb + (ct * 16 + fr) * 272 + ks * 64 + g * 16), aq = *(const bf16x8*)(sb + SC_QN + (ct * 16 + fr) * 272 + ks * 64 + g * 16);
            vn = mfma16(aw, bs, vn); oq = mfma16(aq, bs, oq); }
        oq = oq * rs;
        { u32x2 w; w.x = pk2(vn[0], vn[1]); w.y = pk2(vn[2], vn[3]); *(u32x2*)(VT + (en * 16 + fr) * 72 + ct * 16 + 4 * g) = w;
          const f32x4 vs = vn * cs; w.x = pk2(vs[0], vs[1]); w.y = pk2(vs[2], vs[3]); *(u32x2*)(VS + (en * 16 + fr) * 72 + ct * 16 + 4 * g) = w; }
        LDSBAR();
        S0 = S0 * gl; S1 = S1 * gl;
#pragma unroll
        for (int ks = 0; ks < 2; ++ks) {
            const bf16x8 bv = *(const bf16x8*)(VT + (en * 16 + fr) * 72 + ks * 32 + g * 8);
            const bf16x8 bv2 = *(const bf16x8*)(VS + (en * 16 + fr) * 72 + ks * 32 + g * 8);
            const bf16x8 aqk = *(const bf16x8*)(sb + SC_QK + (ct * 16 + fr) * 144 + ks * 64 + g * 16);
            const bf16x8 ak0 = *(const bf16x8*)(sb + SC_KNT + (kt0 * 16 + fr) * 144 + ks * 64 + g * 16), ak1 = *(const bf16x8*)(sb + SC_KNT + ((kt0 + 1) * 16 + fr) * 144 + ks * 64 + g * 16);
            oq = mfma16(aqk, bv, oq); S0 = mfma16(ak0, bv2, S0); S1 = mfma16(ak1, bv2, S1);
        }
#pragma unroll
        for (int r = 0; r < 4; ++r) O[(size_t)(m0 + ct * 16 + 4 * g + r) * 512 + h * 128 + e0 + fr] = oq[r];
        { u32x2 w; w.x = pk2(S0[0], S0[1]); w.y = pk2(S0[2], S0[3]); *(u32x2*)(ST + (en * 16 + fr) * 136 + kt0 * 16 + 4 * g) = w;
          w.x = pk2(S1[0], S1[1]); w.y = pk2(S1[2], S1[3]); *(u32x2*)(ST + (en * 16 + fr) * 136 + (kt0 + 1) * 16 + 4 * g) = w; }
        if (step + 1 < 36) scan_lwrite(sm + SC_BASE + ((step + 1) & 1) * SC_STAGE, R, tid);
        if (step + 2 < 36) scan_gload(R, p, step + 2, b, h, dir, es, tid);
        LDSBAR();
    }
    __syncthreads();
}
__device__ __forceinline__ void dn_comb_token(const P& p, int m, int lane) {
    const float* o = (const float*)(p.ws + WS_O) + (size_t)m * 512 + lane * 8;
    const float* o2 = (const float*)(p.ws + WS_KN) + (size_t)m * 512 + lane * 8;
    const f32x4 a0 = *(const f32x4*)o + *(const f32x4*)o2, a1 = *(const f32x4*)(o + 4) + *(const f32x4*)(o2 + 4);
    float ss = a0[0] * a0[0] + a0[1] * a0[1] + a0[2] * a0[2] + a0[3] * a0[3] + a1[0] * a1[0] + a1[1] * a1[1] + a1[2] * a1[2] + a1[3] * a1[3];
    ss += __shfl_xor(ss, 1); ss += __shfl_xor(ss, 2); ss += __shfl_xor(ss, 4); ss += __shfl_xor(ss, 8);
    const float rn = 1.0f / sqrtf(ss * (1.f / 128.f) + EPS);
    const int e = (lane & 15) * 8;
    const f32x4 w0 = *(const f32x4*)(p.dn_norm_w + e), w1 = *(const f32x4*)(p.dn_norm_w + e + 4);
    const u32x4 zv = *(const u32x4*)((const bf16_t*)(p.ws + WS_Z) + (size_t)m * 512 + lane * 8);
    float y[8];
    y[0] = a0[0] * rn * w0[0] * siluf(bflo(zv.x)); y[1] = a0[1] * rn * w0[1] * siluf(bfhi(zv.x)); y[2] = a0[2] * rn * w0[2] * siluf(bflo(zv.y)); y[3] = a0[3] * rn * w0[3] * siluf(bfhi(zv.y));
    y[4] = a1[0] * rn * w1[0] * siluf(bflo(zv.z)); y[5] = a1[1] * rn * w1[1] * siluf(bfhi(zv.z)); y[6] = a1[2] * rn * w1[2] * siluf(bflo(zv.w)); y[7] = a1[3] * rn * w1[3] * siluf(bfhi(zv.w));
    u32x4 ov; ov.x = pk2(y[0], y[1]); ov.y = pk2(y[2], y[3]); ov.z = pk2(y[4], y[5]); ov.w = pk2(y[6], y[7]);
    *(u32x4*)((bf16_t*)(p.ws + WS_A) + (size_t)m * 1024 + 512 + lane * 8) = ov;
}

__device__ __forceinline__ void dn_comb_token2(const P& p, int m0, int m1, int lane) {
    const int mm[2] = {m0, m1};
    f32x4 a0[2], a1[2]; u32x4 zv[2];
#pragma unroll
    for (int k = 0; k < 2; ++k) {
        const float* o = (const float*)(p.ws + WS_O) + (size_t)mm[k] * 512 + lane * 8;
        const float* o2 = (const float*)(p.ws + WS_KN) + (size_t)mm[k] * 512 + lane * 8;
        a0[k] = *(const f32x4*)o + *(const f32x4*)o2; a1[k] = *(const f32x4*)(o + 4) + *(const f32x4*)(o2 + 4);
        zv[k] = *(const u32x4*)((const bf16_t*)(p.ws + WS_Z) + (size_t)mm[k] * 512 + lane * 8);
    }
    const int e = (lane & 15) * 8;
    const f32x4 w0 = *(const f32x4*)(p.dn_norm_w + e), w1 = *(const f32x4*)(p.dn_norm_w + e + 4);
#pragma unroll
    for (int k = 0; k < 2; ++k) {
        float ss = a0[k][0] * a0[k][0] + a0[k][1] * a0[k][1] + a0[k][2] * a0[k][2] + a0[k][3] * a0[k][3] + a1[k][0] * a1[k][0] + a1[k][1] * a1[k][1] + a1[k][2] * a1[k][2] + a1[k][3] * a1[k][3];
        ss += __shfl_xor(ss, 1); ss += __shfl_xor(ss, 2); ss += __shfl_xor(ss, 4); ss += __shfl_xor(ss, 8);
        const float rn = 1.0f / sqrtf(ss * (1.f / 128.f) + EPS);
        float y[8];
        y[0] = a0[k][0] * rn * w0[0] * siluf(bflo(zv[k].x)); y[1] = a0[k][1] * rn * w0[1] * siluf(bfhi(zv[k].x)); y[2] = a0[k][2] * rn * w0[2] * siluf(bflo(zv[k].y)); y[3] = a0[k][3] * rn * w0[3] * siluf(bfhi(zv[k].y));
        y[4] = a1[k][0] * rn * w1[0] * siluf(bflo(zv[k].z)); y[5] = a1[k][1] * rn * w1[1] * siluf(bfhi(zv[k].z)); y[6] = a1[k][2] * rn * w1[2] * siluf(bflo(zv[k].w)); y[7] = a1[k][3] * rn * w1[3] * siluf(bfhi(zv[k].w));
        u32x4 ov; ov.x = pk2(y[0], y[1]); ov.y = pk2(y[2], y[3]); ov.z = pk2(y[4], y[5]); ov.w = pk2(y[6], y[7]);
        if (k == 0 || m1 != m0) *(u32x4*)((bf16_t*)(p.ws + WS_A) + (size_t)mm[k] * 1024 + 512 + lane * 8) = ov;
    }
}
#define LAS __attribute__((address_space(3)))
#define XB_TMO      128
#define XB_XCNT(j)  (256  + 64 * (j))
#define XB_XSUB(j)  (1280 + 64 * (j))
#define XB_XGEN(j)  (2304 + 64 * (j))
#define XB_TOP      3328
#define XB_TOPGEN   3392
#define XCD_BAR_WORDS 3456
#define XB_SPIN_CAP (1u << 18)

__device__ __forceinline__ unsigned xb_ld(unsigned* p)              { return __hip_atomic_load(p, __ATOMIC_RELAXED, __HIP_MEMORY_SCOPE_AGENT); }
__device__ __forceinline__ unsigned xb_add(unsigned* p, unsigned v) { return __hip_atomic_fetch_add(p, v, __ATOMIC_RELAXED, __HIP_MEMORY_SCOPE_AGENT); }
__device__ __forceinline__ unsigned xb_xcc_id() { return (unsigned)__builtin_amdgcn_s_getreg((3 << 11) | 20) & 0xFu; }
#define XB_SPIN(cond, bar) do { unsigned _sp = 0; while (cond) { __builtin_amdgcn_s_sleep(1); \
    if ((++_sp & 255u) == 0u) { if (xb_ld(&(bar)[XB_TMO])) break; if (_sp > XB_SPIN_CAP) { atomicAdd(&(bar)[XB_TMO], 1u); break; } } } } while (0)

struct XcdBarrier {
    unsigned* bar; unsigned x;
    volatile LAS unsigned* st;
};

__device__ __forceinline__ XcdBarrier xcd_barrier_post(unsigned* bar, volatile LAS unsigned* st) {
    XcdBarrier b; b.bar = bar; b.x = xb_xcc_id(); b.st = st;
    if (threadIdx.x == 0) (void)xb_add(&bar[XB_XCNT(b.x)], 1u);
    return b;
}
__device__ __forceinline__ void xcd_barrier_complete(unsigned* bar, unsigned x, unsigned& nloc, unsigned& nx) {
    const unsigned G = gridDim.x * gridDim.y * gridDim.z;
    unsigned sum, cnt, mine, sp = 0u;
    for (;;) {
        sum = 0u; cnt = 0u; mine = 0u;
#pragma unroll
        for (unsigned j = 0; j < 16; ++j) { const unsigned c = xb_ld(&bar[XB_XCNT(j)]); sum += c; cnt += (c > 0u) ? 1u : 0u; mine = (j == x) ? c : mine; }
        if (sum == G) break;
        __builtin_amdgcn_s_sleep(1);
        if ((++sp & 255u) == 0u) { if (xb_ld(&bar[XB_TMO])) break; if (sp > XB_SPIN_CAP) { atomicAdd(&bar[XB_TMO], 1u); break; } }
    }
    nloc = mine > 0u ? mine : 1u; nx = cnt > 0u ? cnt : 1u;
}

__device__ __forceinline__ void xcd_barrier(const XcdBarrier& b) {
    asm volatile("s_waitcnt vmcnt(0)" ::: "memory");
    __syncthreads();
    if (threadIdx.x == 0) {
        unsigned* bar = b.bar;
        __builtin_amdgcn_s_waitcnt(0);
        unsigned nloc = b.st[0], nx = b.st[1];
        if (nloc == 0u) { xcd_barrier_complete(bar, b.x, nloc, nx); b.st[0] = nloc; b.st[1] = nx; }
        const unsigned old = xb_add(&bar[XB_XSUB(b.x)], 1u);
        const unsigned gen = old / nloc;
        if (old + 1u == (gen + 1u) * nloc) {
            __builtin_amdgcn_fence(__ATOMIC_RELEASE, "agent");
            asm volatile("s_waitcnt vmcnt(0)" ::: "memory");
            const unsigned og = xb_add(&bar[XB_TOP], 1u);
            const unsigned tg = og / nx;
            if (og + 1u == (tg + 1u) * nx) xb_add(&bar[XB_TOPGEN], 1u);
            else XB_SPIN(xb_ld(&bar[XB_TOPGEN]) == tg, bar);
            __builtin_amdgcn_fence(__ATOMIC_ACQUIRE, "agent");
            xb_add(&bar[XB_XGEN(b.x)], 1u);
            asm volatile("s_waitcnt vmcnt(0)" ::: "memory");
        } else {
            XB_SPIN(xb_ld(&bar[XB_XGEN(b.x)]) == gen, bar);
            __builtin_amdgcn_fence(__ATOMIC_ACQUIRE, "agent");
            asm volatile("s_waitcnt vmcnt(0)" ::: "memory");
        }
    }
    __syncthreads();
}

#ifndef SKIPMASK
#define SKIPMASK 0
#endif
#define RUN(k) (!((SKIPMASK) & (1 << (k))))
#ifndef REPMASK
#define REPMASK 0
#endif
#define REP(k) for (int rep_ = 0; rep_ < (((REPMASK) >> (k)) & 1) + 1; ++rep_)
__global__ void __launch_bounds__(NTHREADS) mega_fwd(P p) {
    extern __shared__ __attribute__((aligned(16))) unsigned char lds[];
    cg::grid_group grid = cg::this_grid();
    const int G = gridDim.x, ngw = G * 8;
    P q;
    int tidl = threadIdx.x, lane = 0, wave = 0, gw = 0;
#define PH() do { unsigned zo_ = 0u; asm volatile("" : "+v"(zo_), "+v"(tidl)); zo_ = __builtin_amdgcn_readfirstlane(zo_); \
        typedef const __attribute__((address_space(4))) P* KP_; KP_ kp_ = (KP_)((const __attribute__((address_space(4))) char*)__builtin_amdgcn_kernarg_segment_ptr() + zo_); \
        q.x = kp_->x; q.c = kp_->c; q.ctx = kp_->ctx; q.c_ctx = kp_->c_ctx; q.ada_w = kp_->ada_w; q.ada_b = kp_->ada_b; q.norm_g = kp_->norm_g; q.w_up = kp_->w_up; q.w_dn = kp_->w_dn; q.e_in = kp_->e_in; \
        q.e_out = kp_->e_out; q.rpb = kp_->rpb; q.conv_w = kp_->conv_w; q.a_log = kp_->a_log; q.dt_bias = kp_->dt_bias; q.dn_norm_w = kp_->dn_norm_w; q.o_in = kp_->o_in; q.o_out = kp_->o_out; q.sink = kp_->sink; q.fin_g = kp_->fin_g; \
        q.out = kp_->out; q.ws = kp_->ws; lane = tidl & 63; wave = __builtin_amdgcn_readfirstlane(tidl >> 6); gw = blockIdx.x * 8 + wave; } while (0)
#define GSYNC() do { xcd_barrier(bar); if ((REPMASK) & (1 << 20)) xcd_barrier(bar); } while (0)
#define LDSL ((PG8_LAS unsigned char*)lds)
#define HLAT (q.out)
#define HCTX ((float*)(q.ws + WS_HCTX))
#define ABUF ((bf16_t*)(q.ws + WS_A))
#define MODP ((const float*)(q.ws + WS_MOD))

    volatile LAS unsigned* MISC = (volatile LAS unsigned*)(LDSL + LDS_MISC);
    if (threadIdx.x < 16) MISC[threadIdx.x] = 0u;
    __syncthreads();
    XcdBarrier bar = xcd_barrier_post((unsigned*)p.ws, MISC);
    PH();
    if (RUN(0)) REP(0) ph_prologue(q, lds, tidl, wave, lane, G);
    if (p.ws == nullptr) grid.sync();
    GSYNC();

    for (int l = 0; l < 2; ++l) {
        for (int stg = 0; stg < 3; ++stg) {
            const bool first = (l == 0 && stg == 0);
            const int cs = l * 3 + stg;
            const int rows = (l == 1 && stg == 2) ? MLAT : MALL;
            PH();
            if (RUN(1)) REP(1) ph_normmod(q, first ? q.x : HLAT, first ? q.ctx : HCTX, rows, l, stg, gw, ngw, lane);
            GSYNC();
            size_t ra_off, rb_off; int RM, RK; float rscale;
            if (stg != 1) {
                const int f = stg >> 1;
                PH();
                {
                    pg8::Gemm gm{ABUF, (const bf16_t*)(q.ws + WS_WUP) + (size_t)(l * 2 + f) * 2 * DFF * DM, rows, 2 * DFF, DM};
                    pg8::StaticOrder S; S.init(rows, 2 * DFF, G, (int)blockIdx.x);
                    EpiSwiglu E{(bf16_t*)(q.ws + WS_ACT)};
                    if (RUN(2)) REP(2) pg8::gemm_phase<EpiSwiglu, pg8::StaticOrder, true, true>(LDSL, gm, S, E);
                    if (first) {
                        const int rem = ((rows / 256) * 22) % G;
                        __syncthreads();
                        if (rem > 0 && (int)blockIdx.x >= rem) run_transposes(q, lds, wave, lane, 0x010u, ((int)blockIdx.x - rem) * 8 + wave, (G - rem) * 8);
                        else if (rem == 0) run_transposes(q, lds, wave, lane, 0x010u, (int)blockIdx.x * 8 + wave, G * 8);
                    }
                }
                ra_off = WS_ACT; rb_off = WS_WDN + (size_t)(l * 2 + f) * DM * DFF * 2; RM = rows; RK = DFF; rscale = 0.5f;
            } else if (l == 0) {
                PH();
                {
                    pg8::Gemm gm{ABUF, (const bf16_t*)(q.ws + WS_WEIN), MALL, 3840, DM};
                    pg8::StaticOrder S; S.init(MALL, 3840, G, (int)blockIdx.x);
                    EpiEvenIn E{(bf16_t*)(q.ws + WS_NAQK), (bf16_t*)(q.ws + WS_NAVT), (bf16_t*)(q.ws + WS_DNPRE), (bf16_t*)(q.ws + WS_Z), (float*)(q.ws + WS_AB)};
                    if (RUN(4)) REP(4) pg8::gemm_phase<EpiEvenIn, pg8::StaticOrder, true, true>(LDSL, gm, S, E);
                }
                GSYNC();
                PH();
                {
                    const int vcu = (G % 8 == 0) ? ((int)blockIdx.x % 8) * (G / 8) + (int)blockIdx.x / 8 : (int)blockIdx.x;
                    if (RUN(5)) REP(5) for (int t = vcu * 8 + wave; t < 3072; t += ngw) na_task(q, t, lane, (float*)(lds + wave * 12288));
                }
                PH();
                if (RUN(6)) REP(6) for (int m = gw * 4; m < MALL; m += ngw * 4) dn_conv_token4(q, m, lane);
                GSYNC();
                PH();
                if (RUN(7)) REP(7) for (int t = blockIdx.x; t < 1152; t += G) dn_prep_task(q, t, lds, tidl);
                GSYNC();
                PH();
                if (RUN(8)) REP(8) for (int t = blockIdx.x; t < 256; t += G) dn_scan_task(q, t, lds, tidl);
                GSYNC();
                PH();
                if (RUN(9)) REP(9) for (int m = gw; m < MALL; m += 2 * ngw) dn_comb_token2(q, m, m + ngw < MALL ? m + ngw : m, lane);
                ra_off = WS_A; rb_off = WS_WEOUT; RM = MALL; RK = DM; rscale = 1.0f;
            } else {
                for (int part = 0; part < 2; ++part) {
                    const int Mp = part ? 2048 : MLAT, Np = part ? 512 : 1536;
                    PH();
                    pg8::Gemm gm{ABUF + (part ? (size_t)MLAT * DM : 0), (const bf16_t*)(q.ws + WS_WOIN) + (part ? (size_t)1024 * DM : 0), Mp, Np, DM};
                    pg8::StaticOrder S; S.init(Mp, Np, G, part ? (int)((blockIdx.x + G / 2) % G) : (int)blockIdx.x);
                    EpiOddIn E{(bf16_t*)(q.ws + WS_SWQ), (bf16_t*)(q.ws + WS_SWK), (bf16_t*)(q.ws + WS_SWVT), part ? 64 : 0, part ? 4 : 0};
                    if (RUN(10)) REP(10) pg8::gemm_phase<EpiOddIn, pg8::StaticOrder, true, true>(LDSL, gm, S, E);
                }
                GSYNC();
                PH();
                {
                    const int vcu = (G % 8 == 0) ? ((int)blockIdx.x % 8) * (G / 8) + (int)blockIdx.x / 8 : (int)blockIdx.x;
                    if (RUN(11)) REP(11) for (int t = vcu; t < 512; t += G) { swa_block_task(q, t, lds, tidl); __syncthreads(); }
                }
                ra_off = WS_A; rb_off = WS_WOOUT; RM = MLAT; RK = DM; rscale = 1.0f;
            }
            GSYNC();
            PH();
            {
                pg8::Gemm gm{(const bf16_t*)(q.ws + ra_off), (const bf16_t*)(q.ws + rb_off), RM, DM, RK};
                pg8::StaticOrder S; S.init(RM, DM, G, (int)blockIdx.x);
                EpiResid E{first ? q.x : HLAT, first ? q.ctx : HCTX, HLAT, HCTX, MODP + (size_t)l * 9 * 9216 + (3 * stg + 2) * DM, rscale};
                if (RUN(3)) REP(3) pg8::gemm_phase<EpiResid, pg8::StaticOrder, true, true>(LDSL, gm, S, E);
                {
                    const int nbusy = (RM / 256) * 4 - G;
                    const unsigned tmask = cs == 0 ? 0x322u : (cs == 2 ? 0xCCCu : 0u);
                    if (tmask && nbusy > 0 && nbusy < G && (int)blockIdx.x >= nbusy) { __syncthreads(); run_transposes(q, lds, wave, lane, tmask, ((int)blockIdx.x - nbusy) * 8 + wave, (G - nbusy) * 8); }
                    else if (tmask && !(nbusy > 0 && nbusy < G)) { __syncthreads(); run_transposes(q, lds, wave, lane, tmask, (int)blockIdx.x * 8 + wave, G * 8); }
                }
            }
            GSYNC();
        }
    }
    PH();
    if (RUN(12)) REP(12) ph_final(q, gw, ngw, lane);
}

extern "C" void kernel_launch(void* const* d_in, const int* in_sizes, int n_in, void* d_out, int out_size, void* d_ws, size_t ws_size, hipStream_t stream) {
    static int grid = 0;
    if (grid == 0) {
        int dev = 0, cus = 0, per_cu = 0;
        hipGetDevice(&dev);
        hipDeviceGetAttribute(&cus, hipDeviceAttributeMultiprocessorCount, dev);
        hipFuncSetAttribute((const void*)mega_fwd, hipFuncAttributeMaxDynamicSharedMemorySize, LDS_BYTES);
        hipOccupancyMaxActiveBlocksPerMultiprocessor(&per_cu, (const void*)mega_fwd, NTHREADS, LDS_BYTES);
        if (per_cu < 1) per_cu = 1;
        grid = cus * per_cu;
        if (n_in != 20 || ws_size < 350 * MiB) fprintf(stderr, "kernel_launch: unexpected n_in %d / ws_size %zu\n", n_in, ws_size);
    }
    P p{};
    const float** pp = (const float**)&p;
    for (int i = 0; i < 20; ++i) pp[i] = (const float*)d_in[i];
    p.out = (float*)d_out; p.ws = (unsigned char*)d_ws;
    void* args[] = {&p};
    (void)hipMemsetAsync(d_ws, 0, 16384, stream);
    hipError_t e = hipLaunchCooperativeKernel((const void*)mega_fwd, dim3(grid), dim3(NTHREADS), args, LDS_BYTES, stream);
    if (e != hipSuccess) fprintf(stderr, "cooperative launch failed: %s (grid %d)\n", hipGetErrorString(e), grid);
}
```

```cpp
#include <hip/hip_runtime.h>
#include <hip/hip_cooperative_groups.h>
#include <cstdio>
#include <cstdint>
namespace cg = cooperative_groups;
namespace pg8 {
#define PG8_LAS __attribute__((address_space(3)))
typedef unsigned short bf16_t;
typedef short bf16x8 __attribute__((ext_vector_type(8)));
typedef float f32x4 __attribute__((ext_vector_type(4)));
typedef unsigned u32x4 __attribute__((ext_vector_type(4)));
constexpr int BM = 256, BK = 64, HALF = 128, HTB = HALF * BK * 2  , STAGE_BYTES = 8 * HTB, NXCD = 8, WGM = 4;

__host__ __device__ __forceinline__ int lds_byte(int r, int c) { const int st = (r >> 4) * 2 + (c >> 5), rr = r & 15, cc = c & 31, ob = rr * 64 + cc * 2; return st * 1024 + (ob ^ (((ob >> 9) & 1) << 5)); }
__host__ __device__ __forceinline__ void stage_rc(int b, int& R, int& C) { const int st = b / 1024, sb = b % 1024, swz = sb ^ (((sb >> 9) & 1) << 5); R = (st >> 1) * 16 + swz / 64; C = (st & 1) * 32 + (swz % 64) / 2; }
__host__ __device__ __forceinline__ int perm32(int rho) { const int n = rho >> 4, i = rho & 15; return 8 * (i >> 2) + 4 * n + (i & 3); }

struct Unit { int pm, pn; };
struct Gemm { const bf16_t* A; const bf16_t* Bt; int M, N, K; };

struct StaticOrder {
    int nM, nN, nwg, G, c;
    __host__ __device__ void init(int M, int N, int G_, int c_) { nM = M / BM; nN = N / BM; nwg = nM * nN; G = G_; c = c_; }
    __host__ __device__ bool next(int i, Unit& u) const {
        const long L = (long)i * G + c; if (L >= nwg) return false;
        int wgid = (int)L; { const int q = nwg / NXCD, r = nwg % NXCD, xcd = wgid % NXCD, off = wgid / NXCD; wgid = (xcd < r ? xcd * (q + 1) : r * (q + 1) + (xcd - r) * q) + off; }
        const int nig = WGM * nN, gid = wgid / nig, fm = gid * WGM, gsz = (nM - fm) < WGM ? (nM - fm) : WGM;
        u.pm = fm + ((wgid % nig) % gsz); u.pn = (wgid % nig) / gsz; return true;
    }
    __device__ __forceinline__ void a_ready(const Unit&) const {}
    __device__ __forceinline__ void done(const Unit&) const {}
};

template <class Epi, class Sched, bool ALIGN_EPI = false, bool SP2 = false>
__device__ __forceinline__ void gemm_phase(PG8_LAS unsigned char* lds, const Gemm g, const Sched& S, const Epi& E) {
    int tid_l = threadIdx.x; asm volatile("" : "+v"(tid_l));
    const int tid = tid_l, wid = __builtin_amdgcn_readfirstlane(tid >> 6), lane = tid & 63, wr = wid >> 2, wc = wid & 3, fr = lane & 15, fq = lane >> 4;
    const int K = g.K, nt = K / BK;
    unsigned voffA[2], voffB[2];
#pragma unroll
    for (int i = 0; i < 2; ++i) { int R, C; stage_rc(tid * 16 + i * 8192, R, C); const int Rb = Epi::PERM ? ((R & ~31) + perm32(R & 31)) : R;
        voffA[i] = (unsigned)(R * K + C) * 2u; voffB[i] = (unsigned)(Rb * K + C) * 2u; }
    const size_t kstep = (size_t)(BK * 2);
    const size_t hstep = (size_t)HALF * K * 2;
    const size_t tstep = 2 * hstep;
    const unsigned ldsw = (unsigned)wid * 1024u;
    const int aoff = lds_byte(wr * 64 + fr, fq * 8), boff = lds_byte(wc * 32 + fr, fq * 8);
#define PG8_SA(b, h) (((b) * 2 + (h)) * HTB)
#define PG8_SB(b, h) ((4 + (b) * 2 + (h)) * HTB)
#define PG8_STAGE(bufoff, gbase, voff) do { _Pragma("unroll") for (int _i = 0; _i < 2; ++_i) \
        __builtin_amdgcn_global_load_lds((const unsigned*)((const char*)(gbase) + (voff)[_i]), (PG8_LAS unsigned*)(lds + (bufoff) + ldsw + _i * 8192), 16, 0, 0); } while (0)
#define PG8_LDA(dst, b, h) do { _Pragma("unroll") for (int m = 0; m < 4; ++m) _Pragma("unroll") for (int k = 0; k < 2; ++k) dst[m][k] = *(const PG8_LAS bf16x8*)(lds + PG8_SA(b, h) + aoff + m * 2048 + k * 1024); } while (0)
#define PG8_LDB(dst, b, h) do { _Pragma("unroll") for (int n = 0; n < 2; ++n) _Pragma("unroll") for (int k = 0; k < 2; ++k) dst[n][k] = *(const PG8_LAS bf16x8*)(lds + PG8_SB(b, h) + boff + n * 2048 + k * 1024); } while (0)
#define PG8_MMA(ai, bj, At, Bt) do { __builtin_amdgcn_s_setprio(1); _Pragma("unroll") for (int m = 0; m < 4; ++m) _Pragma("unroll") for (int n = 0; n < 2; ++n) _Pragma("unroll") for (int k = 0; k < 2; ++k) \
        acc[ai][bj][m][n] = __builtin_amdgcn_mfma_f32_16x16x32_bf16(Bt[n][k], At[m][k], acc[ai][bj][m][n], 0, 0, 0); __builtin_amdgcn_s_setprio(0); } while (0)
#define PG8_WAIT_V(n) asm volatile("s_waitcnt vmcnt(" #n ")" ::: "memory")
#define PG8_WAIT_L(n) asm volatile("s_waitcnt lgkmcnt(" #n ")" ::: "memory")
#define PG8_BAR __builtin_amdgcn_s_barrier()
#define PG8_SCHED __builtin_amdgcn_sched_barrier(0)
    Unit cur, nxt; int ui = 0;
    if (!S.next(0, cur)) return;
    f32x4 acc[2][2][4][2];
#pragma unroll
    for (int a = 0; a < 2; ++a)
#pragma unroll
        for (int b = 0; b < 2; ++b)
#pragma unroll
            for (int m = 0; m < 4; ++m)
#pragma unroll
                for (int n = 0; n < 2; ++n) acc[a][b][m][n] = (f32x4){0.f, 0.f, 0.f, 0.f};
    bf16x8 At[4][2], B0[2][2], B1[2][2];
    const char* cA = (const char*)g.A + (size_t)cur.pm * tstep; const char* cB = (const char*)g.Bt + (size_t)cur.pn * tstep;
    S.a_ready(cur);
    if constexpr (SP2) {
        PG8_STAGE(PG8_SB(0, 0), cB, voffB); PG8_STAGE(PG8_SB(0, 1), cB + hstep, voffB); PG8_STAGE(PG8_SA(0, 0), cA, voffA); PG8_STAGE(PG8_SA(0, 1), cA + hstep, voffA);
        if (wr == 1) PG8_BAR;
        PG8_WAIT_V(2); PG8_BAR;
        PG8_STAGE(PG8_SB(1, 0), cB + kstep, voffB); PG8_STAGE(PG8_SA(1, 0), cA + kstep, voffA); PG8_STAGE(PG8_SB(1, 1), cB + hstep + kstep, voffB);
        PG8_WAIT_V(6); PG8_BAR;
    } else {
        PG8_STAGE(PG8_SB(0, 0), cB, voffB); PG8_STAGE(PG8_SA(0, 0), cA, voffA); PG8_STAGE(PG8_SB(0, 1), cB + hstep, voffB); PG8_STAGE(PG8_SA(0, 1), cA + hstep, voffA);
        if (wr == 1) PG8_BAR;
        PG8_WAIT_V(4); PG8_BAR;
        PG8_STAGE(PG8_SB(1, 0), cB + kstep, voffB); PG8_STAGE(PG8_SA(1, 0), cA + kstep, voffA); PG8_STAGE(PG8_SB(1, 1), cB + hstep + kstep, voffB);
        PG8_WAIT_V(6); PG8_BAR;
    }
    for (;;) {
        const bool has_next = S.next(ui + 1, nxt);
        const char* nA = has_next ? (const char*)g.A + (size_t)nxt.pm * tstep : cA; const char* nB = has_next ? (const char*)g.Bt + (size_t)nxt.pn * tstep : cB;
        for (int t = 0; t < nt; t += 2) {
            const bool last = (t == nt - 2);
            const char* a1 = cA + (size_t)(t + 1) * kstep;
            const char* a2 = last ? nA : cA + (size_t)(t + 2) * kstep; const char* b2 = last ? nB : cB + (size_t)(t + 2) * kstep;
            const char* a3 = a2 + kstep; const char* b3 = b2 + kstep;
            if (last && has_next) S.a_ready(nxt);
            if constexpr (SP2) {
            PG8_LDB(B0, 0, 0); PG8_LDB(B1, 0, 1); PG8_SCHED; PG8_LDA(At, 0, 0); PG8_STAGE(PG8_SA(1, 1), a1 + hstep, voffA);
            PG8_WAIT_V(8); PG8_WAIT_L(0); PG8_BAR; PG8_MMA(0, 0, At, B0); PG8_MMA(0, 1, At, B1); PG8_BAR; PG8_SCHED;
            PG8_LDA(At, 0, 1); PG8_STAGE(PG8_SB(0, 0), b2, voffB); PG8_STAGE(PG8_SB(0, 1), b2 + hstep, voffB); PG8_STAGE(PG8_SA(0, 0), a2, voffA);
            PG8_WAIT_V(8); PG8_WAIT_L(0); PG8_BAR; PG8_MMA(1, 0, At, B0); PG8_MMA(1, 1, At, B1); PG8_BAR; PG8_SCHED;
            PG8_LDB(B0, 1, 0); PG8_LDB(B1, 1, 1); PG8_SCHED; PG8_LDA(At, 1, 0); PG8_STAGE(PG8_SA(0, 1), a2 + hstep, voffA);
            PG8_WAIT_V(8); PG8_WAIT_L(0); PG8_BAR; PG8_MMA(0, 0, At, B0); PG8_MMA(0, 1, At, B1); PG8_BAR; PG8_SCHED;
            PG8_LDA(At, 1, 1); PG8_STAGE(PG8_SB(1, 0), b3, voffB); PG8_STAGE(PG8_SB(1, 1), b3 + hstep, voffB); PG8_STAGE(PG8_SA(1, 0), a3, voffA);
            PG8_WAIT_V(8); PG8_WAIT_L(0); PG8_BAR; PG8_MMA(1, 0, At, B0); PG8_MMA(1, 1, At, B1); PG8_BAR; PG8_SCHED;
            } else {
            PG8_LDB(B0, 0, 0); PG8_SCHED; PG8_LDA(At, 0, 0); PG8_STAGE(PG8_SA(1, 1), a1 + hstep, voffA);
            PG8_WAIT_L(8); PG8_BAR; PG8_WAIT_L(0); PG8_MMA(0, 0, At, B0); PG8_BAR; PG8_SCHED;
            PG8_LDB(B1, 0, 1); PG8_STAGE(PG8_SB(0, 0), b2, voffB);
            PG8_BAR; PG8_WAIT_L(0); PG8_MMA(0, 1, At, B1); PG8_BAR;
            PG8_LDA(At, 0, 1); PG8_STAGE(PG8_SA(0, 0), a2, voffA);
            PG8_BAR; PG8_WAIT_L(0); PG8_MMA(1, 0, At, B0); PG8_BAR; PG8_SCHED;
            PG8_STAGE(PG8_SB(0, 1), b2 + hstep, voffB);
            PG8_WAIT_V(6); PG8_BAR; PG8_MMA(1, 1, At, B1); PG8_BAR;
            PG8_LDB(B0, 1, 0); PG8_SCHED; PG8_LDA(At, 1, 0); PG8_STAGE(PG8_SA(0, 1), a2 + hstep, voffA);
            PG8_WAIT_L(8); PG8_BAR; PG8_WAIT_L(0); PG8_MMA(0, 0, At, B0); PG8_BAR; PG8_SCHED;
            PG8_LDB(B1, 1, 1); PG8_STAGE(PG8_SB(1, 0), b3, voffB);
            PG8_BAR; PG8_WAIT_L(0); PG8_MMA(0, 1, At, B1); PG8_BAR;
            PG8_LDA(At, 1, 1); PG8_STAGE(PG8_SA(1, 0), a3, voffA);
            PG8_BAR; PG8_WAIT_L(0); PG8_MMA(1, 0, At, B0); PG8_BAR; PG8_SCHED;
            PG8_STAGE(PG8_SB(1, 1), b3 + hstep, voffB);
            PG8_WAIT_V(6); PG8_BAR; PG8_MMA(1, 1, At, B1); PG8_BAR;
            }
        }
        if constexpr (ALIGN_EPI) { if (wr == 0) PG8_BAR; }
        if constexpr (!Epi::AFTER_DRAIN) { E(acc, cur, wr, wc, fr, fq); S.done(cur); }
        if (!has_next) break;
#pragma unroll
        for (int a = 0; a < 2; ++a)
#pragma unroll
            for (int b = 0; b < 2; ++b)
#pragma unroll
                for (int m = 0; m < 4; ++m)
#pragma unroll
                    for (int n = 0; n < 2; ++n) acc[a][b][m][n] = (f32x4){0.f, 0.f, 0.f, 0.f};
        cur = nxt; cA = nA; cB = nB; ++ui;
        if constexpr (ALIGN_EPI) { if (wr == 1) PG8_BAR; }
    }
    PG8_WAIT_V(0);
    if constexpr (!ALIGN_EPI) { if (wr == 0) PG8_BAR; }
    PG8_BAR;
    if constexpr (Epi::AFTER_DRAIN) { E.fused(acc, cur, wr, wc, fr, fq, lds, wid, lane); S.done(cur); }
#undef PG8_SA
#undef PG8_SB
#undef PG8_STAGE
#undef PG8_LDA
#undef PG8_LDB
#undef PG8_MMA
#undef PG8_WAIT_V
#undef PG8_WAIT_L
#undef PG8_BAR
#undef PG8_SCHED
}
}

using pg8::bf16_t; using pg8::bf16x8; using pg8::f32x4; using pg8::Unit;
typedef unsigned u32x4 __attribute__((ext_vector_type(4)));
typedef unsigned u32x2 __attribute__((ext_vector_type(2)));
typedef short s16x4 __attribute__((ext_vector_type(4)));

constexpr int DM = 1024, NBATCH = 8, TLAT = 2048, TCTX = 256, MLAT = 16384, MALL = 18432, DFF = 2816, TT = 2304;
constexpr float EPS = 1e-6f;
constexpr float SCALE_DK = 0.08838834764831845f;
constexpr int NTHREADS = 512;
constexpr int LDS_BYTES = 156672;
constexpr int LDS_MISC = 155648;

constexpr size_t MiB = 1u << 20;
constexpr size_t WS_MOD = 1 * MiB;
constexpr size_t WS_WUP = 2 * MiB;
constexpr size_t WS_WDN = 46 * MiB;
constexpr size_t WS_WEIN = 68 * MiB;
constexpr size_t WS_WEOUT = 76 * MiB;
constexpr size_t WS_WOIN = 78 * MiB;
constexpr size_t WS_WOOUT = 81 * MiB;
constexpr size_t WS_HCTX = 83 * MiB;
constexpr size_t WS_A = 91 * MiB;
constexpr size_t WS_ACT = 127 * MiB;
constexpr size_t WS_NAQK = 127 * MiB;
constexpr size_t WS_NAVT = 163 * MiB;
constexpr size_t WS_DNPRE = 181 * MiB;
constexpr size_t WS_Z = 235 * MiB;
constexpr size_t WS_AB = 253 * MiB;
constexpr size_t WS_GB = 255 * MiB;
constexpr size_t WS_QN = 257 * MiB;
constexpr size_t WS_KN = 275 * MiB;
constexpr size_t WS_VV = 293 * MiB;
constexpr size_t WS_RSCS = 311 * MiB;
constexpr size_t WS_O = 314 * MiB;
constexpr size_t WS_NEGW = 127 * MiB;
constexpr size_t WS_UT = 163 * MiB;
constexpr size_t WS_QKC = 199 * MiB;
constexpr size_t WS_KNT = 217 * MiB;
constexpr size_t WS_SWQ = 127 * MiB;
constexpr size_t WS_SWK = 159 * MiB;
constexpr size_t WS_SWVT = 168 * MiB;

struct P {
    const float *x, *c, *ctx, *c_ctx, *ada_w, *ada_b, *norm_g, *w_up, *w_dn, *e_in, *e_out, *rpb, *conv_w, *a_log, *dt_bias, *dn_norm_w, *o_in, *o_out, *sink, *fin_g;
    float* out; unsigned char* ws;
};

__device__ __forceinline__ unsigned f2bf(float f) { unsigned u = __builtin_bit_cast(unsigned, f); return (u + 0x7fffu + ((u >> 16) & 1u)) >> 16; }
__device__ __forceinline__ unsigned pk2(float lo, float hi) { unsigned r; asm("v_cvt_pk_bf16_f32 %0, %1, %2" : "=v"(r) : "v"(lo), "v"(hi)); return r; }
__device__ __forceinline__ float bf2f(unsigned short h) { return __builtin_bit_cast(float, (unsigned)h << 16); }
__device__ __forceinline__ float bflo(unsigned w) { return __builtin_bit_cast(float, w << 16); }
__device__ __forceinline__ float bfhi(unsigned w) { return __builtin_bit_cast(float, w & 0xffff0000u); }
__device__ __forceinline__ float wave_sum(float v) {
#pragma unroll
    for (int o = 1; o < 64; o <<= 1) v += __shfl_xor(v, o);
    return v;
}
__device__ __forceinline__ float xmax32(float x) { unsigned a = __builtin_bit_cast(unsigned, x), b = a; asm volatile("" : "+v"(b)); auto r = __builtin_amdgcn_permlane32_swap(a, b, false, false); return fmaxf(__builtin_bit_cast(float, (unsigned)r[0]), __builtin_bit_cast(float, (unsigned)r[1])); }
__device__ __forceinline__ float xmax16(float x) { unsigned a = __builtin_bit_cast(unsigned, x), b = a; asm volatile("" : "+v"(b)); auto r = __builtin_amdgcn_permlane16_swap(a, b, false, false); return fmaxf(__builtin_bit_cast(float, (unsigned)r[0]), __builtin_bit_cast(float, (unsigned)r[1])); }
__device__ __forceinline__ float siluf(float v) { return v * __builtin_amdgcn_rcpf(1.f + __expf(-v)); }
__device__ __forceinline__ f32x4 mfma16(bf16x8 a, bf16x8 b, f32x4 c) { return __builtin_amdgcn_mfma_f32_16x16x32_bf16(a, b, c, 0, 0, 0); }

struct EpiSwiglu {
    static constexpr bool PERM = false, AFTER_DRAIN = false;
    bf16_t* act;
    __device__ __forceinline__ void operator()(const f32x4 (&acc)[2][2][4][2], const Unit& u, int wr, int wc, int fr, int fq) const {
#pragma unroll
        for (int ai = 0; ai < 2; ++ai)
#pragma unroll
            for (int m = 0; m < 4; ++m) {
                const int row = u.pm * 256 + ai * 128 + wr * 64 + m * 16 + fr;
                const f32x4 g0 = acc[ai][0][m][0], u0 = acc[ai][0][m][1], g1 = acc[ai][1][m][0], u1 = acc[ai][1][m][1];
                u32x4 w;
                w.x = pk2(siluf(g0[0]) * u0[0], siluf(g0[1]) * u0[1]); w.y = pk2(siluf(g0[2]) * u0[2], siluf(g0[3]) * u0[3]);
                w.z = pk2(siluf(g1[0]) * u1[0], siluf(g1[1]) * u1[1]); w.w = pk2(siluf(g1[2]) * u1[2], siluf(g1[3]) * u1[3]);
                *(u32x4*)(act + (size_t)row * DFF + u.pn * 128 + wc * 32 + 8 * fq) = w;
            }
    }
};
struct EpiResid {
    static constexpr bool PERM = false, AFTER_DRAIN = false;
    const float* srclat; const float* srcctx; float* dstlat; float* dstctx; const float* gate; float scale;
    __device__ __forceinline__ void operator()(const f32x4 (&acc)[2][2][4][2], const Unit& u, int wr, int wc, int fr, int fq) const {
        const bool lat = u.pm < 64; const int mr = lat ? (u.pm >> 3) : 8;
        const float* sp = lat ? srclat : srcctx; float* dp = lat ? dstlat : dstctx;
        const int col0 = u.pn * 256 + wc * 32 + 8 * fq;
        const size_t off0 = (size_t)((lat ? u.pm : u.pm - 64) * 256 + wr * 64 + fr) * DM + col0;
        sp += off0; dp += off0;
        const float* gp = gate + (size_t)mr * 9216 + col0;
        f32x4 gv[2][2];
#pragma unroll
        for (int bj = 0; bj < 2; ++bj)
#pragma unroll
            for (int n = 0; n < 2; ++n) gv[bj][n] = *(const f32x4*)(gp + bj * 128 + n * 4) * scale;
#pragma unroll
        for (int ai = 0; ai < 2; ++ai)
#pragma unroll
            for (int m = 0; m < 4; ++m) {
                const int ro = (ai * 128 + m * 16) * DM;
                f32x4 s[2][2];
#pragma unroll
                for (int bj = 0; bj < 2; ++bj)
#pragma unroll
                    for (int n = 0; n < 2; ++n) s[bj][n] = *(const f32x4*)(sp + ro + bj * 128 + n * 4);
#pragma unroll
                for (int bj = 0; bj < 2; ++bj)
#pragma unroll
                    for (int n = 0; n < 2; ++n) *(f32x4*)(dp + ro + bj * 128 + n * 4) = s[bj][n] + gv[bj][n] * acc[ai][bj][m][n];
                asm volatile("" ::: "memory");
            }
    }
};
struct EpiEvenIn {
    static constexpr bool PERM = false, AFTER_DRAIN = false;
    bf16_t* naqk; bf16_t* navt; bf16_t* dnpre; bf16_t* z; float* ab;
    __device__ __forceinline__ void operator()(const f32x4 (&acc)[2][2][4][2], const Unit& u, int wr, int wc, int fr, int fq) const {
        const bool lat = u.pm < 64; const int b = lat ? (u.pm >> 3) : (u.pm - 64); const int tokb = lat ? (u.pm & 7) * 256 : 2048;
        const int rl0 = wr * 64 + fr; const int cl0 = wc * 32 + 4 * fq;
        if (u.pn >= 4 && u.pn < 6) {
            bf16_t* vp = navt + ((size_t)b * 512 + (u.pn - 4) * 256 + cl0) * TT + tokb + rl0;
#pragma unroll
            for (int ai = 0; ai < 2; ++ai)
#pragma unroll
                for (int m = 0; m < 4; ++m) {
#pragma unroll
                    for (int bj = 0; bj < 2; ++bj)
#pragma unroll
                        for (int n = 0; n < 2; ++n) {
                            const f32x4 v = acc[ai][bj][m][n];
#pragma unroll
                            for (int j = 0; j < 4; ++j) vp[(size_t)(bj * 128 + n * 16 + j) * TT + ai * 128 + m * 16] = (bf16_t)f2bf(v[j]);
                        }
                    asm volatile("" ::: "memory");
                }
        } else if (u.pn < 14) {
            bf16_t* base; int ld;
            if (u.pn < 4) { base = naqk + u.pn * 256; ld = 1024; } else if (u.pn < 12) { base = dnpre + (u.pn - 6) * 256; ld = 1536; } else { base = z + (u.pn - 12) * 256; ld = 512; }
            base += (size_t)(u.pm * 256 + rl0) * ld + wc * 32 + 8 * fq;
#pragma unroll
            for (int ai = 0; ai < 2; ++ai)
#pragma unroll
                for (int m = 0; m < 4; ++m) {
                    bf16_t* rp = base + (size_t)(ai * 128 + m * 16) * ld;
#pragma unroll
                    for (int bj = 0; bj < 2; ++bj) { const f32x4 v0 = acc[ai][bj][m][0], v1 = acc[ai][bj][m][1];
                        u32x4 w; w.x = pk2(v0[0], v0[1]); w.y = pk2(v0[2], v0[3]); w.z = pk2(v1[0], v1[1]); w.w = pk2(v1[2], v1[3]); *(u32x4*)(rp + bj * 128) = w; }
                    asm volatile("" ::: "memory");
                }
        } else if (wc == 0) {
            float* rp0 = ab + (size_t)(u.pm * 256 + rl0) * 16 + 4 * fq;
#pragma unroll
            for (int ai = 0; ai < 2; ++ai)
#pragma unroll
                for (int m = 0; m < 4; ++m) *(f32x4*)(rp0 + (size_t)(ai * 128 + m * 16) * 16) = acc[ai][0][m][0];
        }
    }
};
struct EpiOddIn {
    static constexpr bool PERM = false, AFTER_DRAIN = false;
    bf16_t* swq; bf16_t* swk; bf16_t* swvt; int pm0, pn0;
    __device__ __forceinline__ void operator()(const f32x4 (&acc)[2][2][4][2], const Unit& u, int wr, int wc, int fr, int fq) const {
        const int pm = u.pm + pm0, pn = u.pn + pn0;
        const bool lat = pm < 64; const int b = lat ? (pm >> 3) : (pm - 64); const int tokb = lat ? (pm & 7) * 256 : 2048;
        const int rl0 = wr * 64 + fr, cl0 = wc * 32 + 4 * fq;
        if (pn < 5) {
            bf16_t* base; int ld;
            if (pn < 4) { base = swq + pn * 256; ld = 1024; } else { base = swk; ld = 256; }
            base += (size_t)(pm * 256 + rl0) * ld + cl0;
            const float rot = lat ? 1.f : 0.f;
#pragma unroll
            for (int ai = 0; ai < 2; ++ai)
#pragma unroll
                for (int m = 0; m < 4; ++m) {
                    const int tok = tokb + rl0 + ai * 128 + m * 16;
                    const float pos = rot * (float)((wc & 1) ? (tok & 63) : (tok >> 6));
                    bf16_t* rp = base + (size_t)(ai * 128 + m * 16) * ld;
                    float cs[4], sn[4];
#pragma unroll
                    for (int j = 0; j < 4; ++j) { const float a = pos * __builtin_amdgcn_exp2f(-(float)(4 * fq + j) * 0.830482023721841f); cs[j] = __cosf(a); sn[j] = __sinf(a); }
#pragma unroll
                    for (int bj = 0; bj < 2; ++bj) {
                        const f32x4 x1 = acc[ai][bj][m][0], x2 = acc[ai][bj][m][1];
                        u32x2 w1, w2;
                        w1.x = pk2(x1[0] * cs[0] - x2[0] * sn[0], x1[1] * cs[1] - x2[1] * sn[1]); w1.y = pk2(x1[2] * cs[2] - x2[2] * sn[2], x1[3] * cs[3] - x2[3] * sn[3]);
                        w2.x = pk2(x2[0] * cs[0] + x1[0] * sn[0], x2[1] * cs[1] + x1[1] * sn[1]); w2.y = pk2(x2[2] * cs[2] + x1[2] * sn[2], x2[3] * cs[3] + x1[3] * sn[3]);
                        *(u32x2*)(rp + bj * 128) = w1; *(u32x2*)(rp + bj * 128 + 16) = w2;
                    }
                    asm volatile("" ::: "memory");
                }
        } else {
            bf16_t* vp = swvt + ((size_t)b * 256 + cl0) * TT + tokb + rl0;
#pragma unroll
            for (int ai = 0; ai < 2; ++ai)
#pragma unroll
                for (int m = 0; m < 4; ++m) {
#pragma unroll
                    for (int bj = 0; bj < 2; ++bj)
#pragma unroll
                        for (int n = 0; n < 2; ++n) {
                            const f32x4 v = acc[ai][bj][m][n];
#pragma unroll
                            for (int j = 0; j < 4; ++j) vp[(size_t)(bj * 128 + n * 16 + j) * TT + ai * 128 + m * 16] = (bf16_t)f2bf(v[j]);
                        }
                    asm volatile("" ::: "memory");
                }
        }
    }
};

template <class Map>
__device__ __forceinline__ void transpose_item(const float* W, int K, int N, bf16_t* WT, float* scr, int item, int nblk, int lane, Map srccol) {
    const int kb = item / nblk, nb = item % nblk, k0 = 64 * kb, n0 = 32 * nb;
    const int sc = srccol(n0 + (lane & 31));
    float tv[32];
    const float* wp = W + (size_t)(k0 + (lane >> 5)) * N + (sc >= 0 ? sc : 0);
#pragma unroll
    for (int i = 0; i < 32; ++i) tv[i] = wp[(size_t)(2 * i) * N];
#pragma unroll
    for (int i = 0; i < 32; ++i) { const int kk = 2 * i + (lane >> 5); scr[kk * 33 + (lane & 31)] = sc >= 0 ? tv[i] : 0.f; }
    __builtin_amdgcn_s_waitcnt(0); asm volatile("" ::: "memory");
    const int c = lane & 7;
#pragma unroll
    for (int j = 0; j < 4; ++j) { const int n = (lane >> 3) + 8 * j; const float* s = scr + (8 * c) * 33 + n;
        u32x4 o; o.x = pk2(s[0 * 33], s[1 * 33]); o.y = pk2(s[2 * 33], s[3 * 33]); o.z = pk2(s[4 * 33], s[5 * 33]); o.w = pk2(s[6 * 33], s[7 * 33]);
        *(u32x4*)(WT + (size_t)(n0 + n) * K + k0 + 8 * c) = o; }
    __builtin_amdgcn_s_waitcnt(0); asm volatile("" ::: "memory");
}
struct MapId { __device__ int operator()(int n) const { return n; } };
struct MapUp { __device__ int operator()(int c) const { return ((c >> 4) & 1) * DFF + (c >> 8) * 128 + ((c >> 5) & 3) * 32 + ((c >> 2) & 3) * 8 + ((c >> 7) & 1) * 4 + (c & 3); } };
struct MapPad { int lim; __device__ int operator()(int n) const { return n < lim ? n : -1; } };
__device__ __forceinline__ int perm8(int c) { return (c & ~31) + 8 * ((c >> 2) & 3) + 4 * ((c >> 4) & 1) + (c & 3); }
struct MapPerm8 { __device__ int operator()(int c) const { return perm8(c); } };
struct MapEin { __device__ int operator()(int c) const { return c >= 3600 ? -1 : ((c < 1024 || (c >= 1536 && c < 3584)) ? perm8(c) : c); } };

__device__ __forceinline__ int mat_items(int mat) { return mat < 4 ? 16 * 176 : (mat < 8 ? 44 * 32 : (mat == 8 ? 16 * 120 : (mat == 10 ? 16 * 48 : 16 * 32))); }
__device__ __forceinline__ void mat_item(const P& p, float* scr, int mat, int r, int lane) {
    if (mat < 4) transpose_item(p.w_up + (size_t)mat * DM * 2 * DFF, DM, 2 * DFF, (bf16_t*)(p.ws + WS_WUP) + (size_t)mat * 2 * DFF * DM, scr, r, 176, lane, MapUp());
    else if (mat < 8) transpose_item(p.w_dn + (size_t)(mat - 4) * DFF * DM, DFF, DM, (bf16_t*)(p.ws + WS_WDN) + (size_t)(mat - 4) * DM * DFF, scr, r, 32, lane, MapPerm8());
    else if (mat == 8) transpose_item(p.e_in, DM, 3600, (bf16_t*)(p.ws + WS_WEIN), scr, r, 120, lane, MapEin());
    else if (mat == 9) transpose_item(p.e_out, DM, DM, (bf16_t*)(p.ws + WS_WEOUT), scr, r, 32, lane, MapPerm8());
    else if (mat == 10) transpose_item(p.o_in, DM, 1536, (bf16_t*)(p.ws + WS_WOIN), scr, r, 48, lane, MapId());
    else transpose_item(p.o_out, DM, DM, (bf16_t*)(p.ws + WS_WOOUT), scr, r, 32, lane, MapPerm8());
}
__device__ __forceinline__ void run_transposes(const P& p, unsigned char* lds, int wave, int lane, unsigned mask, int wid, int nw) {
    float* scr = (float*)(lds + wave * 8448);
    int base = 0;
#pragma unroll 1
    for (int mat = 0; mat < 12; ++mat) {
        if (!((mask >> mat) & 1u)) continue;
        const int n = mat_items(mat);
        int first = (wid - base % nw + nw) % nw;
#pragma unroll 1
        for (int it = first; it < n; it += nw) mat_item(p, scr, mat, it, lane);
        base += n;
    }
}
__device__ __forceinline__ void ph_prologue(const P& p, unsigned char* lds, int tid, int wave, int lane, int G) {
    run_transposes(p, lds, wave, lane, 0x001u, blockIdx.x * 8 + wave, G * 8);
    __syncthreads();
    float* sv = (float*)lds;
    float* red = (float*)(lds + 36864);
    bool have = false;
    typedef float f32x2_ __attribute__((ext_vector_type(2)));
    for (int task = blockIdx.x; task < 256; task += G) {
        if (!have) {
            for (int i = tid; i < 9 * 1024; i += NTHREADS) { const float v = i < 8192 ? p.c[i] : p.c_ctx[i - 8192]; sv[i] = siluf(v); }
            have = true; __syncthreads();
        }
        const int l = task >> 7, c0 = (task & 127) * 72;
        const bool actv = lane < 36;
        const float* w = p.ada_w + (size_t)l * DM * 9216 + c0 + 2 * (actv ? lane : 0);
        float acc0[9], acc1[9];
#pragma unroll
        for (int r = 0; r < 9; ++r) { acc0[r] = 0.f; acc1[r] = 0.f; }
        const int kb = wave * 128;
#pragma unroll 2
        for (int k4 = 0; k4 < 128; k4 += 4) {
            f32x2_ wv[4];
#pragma unroll
            for (int j = 0; j < 4; ++j) wv[j] = *(const f32x2_*)(w + (size_t)(kb + k4 + j) * 9216);
#pragma unroll
            for (int r = 0; r < 9; ++r) { const f32x4 s4 = *(const f32x4*)(sv + r * 1024 + kb + k4);
                acc0[r] += s4[0] * wv[0].x + s4[1] * wv[1].x + s4[2] * wv[2].x + s4[3] * wv[3].x;
                acc1[r] += s4[0] * wv[0].y + s4[1] * wv[1].y + s4[2] * wv[2].y + s4[3] * wv[3].y; }
        }
        if (actv) {
#pragma unroll
            for (int r = 0; r < 9; ++r) { red[(wave * 9 + r) * 72 + 2 * lane] = acc0[r]; red[(wave * 9 + r) * 72 + 2 * lane + 1] = acc1[r]; }
        }
        __syncthreads();
        for (int i = tid; i < 648; i += NTHREADS) { const int r = i / 72, cc = i % 72; float sum = 0.f;
#pragma unroll
            for (int wv = 0; wv < 8; ++wv) sum += red[(wv * 9 + r) * 72 + cc];
            ((float*)(p.ws + WS_MOD))[((size_t)l * 9 + r) * 9216 + c0 + cc] = sum + p.ada_b[l * 9216 + c0 + cc]; }
        __syncthreads();
    }
}

__device__ __forceinline__ void ph_normmod(const P& p, const float* srclat, const float* srcctx, int rows, int l, int idx, int gw, int ngw, int lane) {
    const float* mod = (const float*)(p.ws + WS_MOD) + (size_t)l * 9 * 9216;
    const float* g = p.norm_g + (l * 3 + idx) * DM;
    bf16_t* A = (bf16_t*)(p.ws + WS_A);
    for (int m = gw; m < rows; m += ngw) {
        const float* src = m < MLAT ? srclat + (size_t)m * DM : srcctx + (size_t)(m - MLAT) * DM;
        const int mr = m < MLAT ? (m >> 11) : 8;
        const float* sh = mod + mr * 9216 + (3 * idx) * DM; const float* sc = sh + DM;
        f32x4 v[4]; float ss = 0.f;
#pragma unroll
        for (int j = 0; j < 4; ++j) { v[j] = *(const f32x4*)(src + 4 * lane + 256 * j); ss += v[j][0] * v[j][0] + v[j][1] * v[j][1] + v[j][2] * v[j][2] + v[j][3] * v[j][3]; }
        const float rstd = 1.0f / sqrtf(wave_sum(ss) * (1.f / DM) + EPS);
#pragma unroll
        for (int j = 0; j < 4; ++j) { const int col = 4 * lane + 256 * j;
            const f32x4 gv = *(const f32x4*)(g + col), shv = *(const f32x4*)(sh + col), scv = *(const f32x4*)(sc + col);
            const f32x4 o = v[j] * rstd * gv * (scv + 1.0f) + shv;
            u32x2 w; w.x = pk2(o[0], o[1]); w.y = pk2(o[2], o[3]); *(u32x2*)(A + (size_t)m * DM + col) = w; }
    }
}
__device__ __forceinline__ void ph_final(const P& p, int gw, int ngw, int lane) {
    for (int m = gw; m < MLAT; m += ngw) {
        float* row = p.out + (size_t)m * DM;
        f32x4 v[4]; float ss = 0.f;
#pragma unroll
        for (int j = 0; j < 4; ++j) { v[j] = *(const f32x4*)(row + 4 * lane + 256 * j); ss += v[j][0] * v[j][0] + v[j][1] * v[j][1] + v[j][2] * v[j][2] + v[j][3] * v[j][3]; }
        const float rstd = 1.0f / sqrtf(wave_sum(ss) * (1.f / DM) + EPS);
#pragma unroll
        for (int j = 0; j < 4; ++j) { const int col = 4 * lane + 256 * j; const f32x4 gv = *(const f32x4*)(p.fin_g + col); *(f32x4*)(row + col) = v[j] * rstd * gv; }
    }
}

#define LDSBAR() do { asm volatile("s_waitcnt lgkmcnt(0)" ::: "memory"); __builtin_amdgcn_s_barrier(); asm volatile("" ::: "memory"); } while (0)
struct AttnState { float m, l; f32x4 o[4]; };
struct AttnKV { bf16x8 a00, a01, a10, a11; s16x4 va[4][2]; float mb[8]; };
struct AttnK { bf16x8 a00, a01, a10, a11; };
struct AttnV { s16x4 va[4][2]; };
__device__ __forceinline__ void attn_load_k(AttnK& k, const bf16_t* k0p, const bf16_t* k1p) {
    k.a00 = *(const bf16x8*)k0p; k.a01 = *(const bf16x8*)(k0p + 32); k.a10 = *(const bf16x8*)k1p; k.a11 = *(const bf16x8*)(k1p + 32);
}
__device__ __forceinline__ void attn_load_v(AttnV& v, const bf16_t* vb, int vds, int v0off, int v1off, int fr) {
#pragma unroll
    for (int dt = 0; dt < 4; ++dt) { const bf16_t* vp = vb + (size_t)(dt * 16 + fr) * vds; v.va[dt][0] = *(const s16x4*)(vp + v0off); v.va[dt][1] = *(const s16x4*)(vp + v1off); }
}
__device__ __forceinline__ void attn_compute_kv(const AttnK& k, const AttnV& v, const float (&mbv)[8], bf16x8 q0, bf16x8 q1, AttnState& st) {
    f32x4 s0 = {0.f, 0.f, 0.f, 0.f}, s1 = {0.f, 0.f, 0.f, 0.f};
    s0 = mfma16(k.a00, q0, s0); s0 = mfma16(k.a01, q1, s0); s1 = mfma16(k.a10, q0, s1); s1 = mfma16(k.a11, q1, s1);
    float sc[8];
#pragma unroll
    for (int r = 0; r < 4; ++r) { sc[r] = s0[r] * 0.125f + mbv[r]; sc[4 + r] = s1[r] * 0.125f + mbv[4 + r]; }
    float mx = sc[0];
#pragma unroll
    for (int i = 1; i < 8; ++i) mx = fmaxf(mx, sc[i]);
    mx = xmax16(xmax32(mx));
    const float mn = fmaxf(st.m, mx), corr = __expf(st.m - mn); st.m = mn;
    float pp[8], ps = 0.f;
#pragma unroll
    for (int i = 0; i < 8; ++i) { pp[i] = __expf(sc[i] - mn); ps += pp[i]; }
    st.l = st.l * corr + ps;
    u32x4 pw; pw.x = pk2(pp[0], pp[1]); pw.y = pk2(pp[2], pp[3]); pw.z = pk2(pp[4], pp[5]); pw.w = pk2(pp[6], pp[7]);
    const bf16x8 pb = __builtin_bit_cast(bf16x8, pw);
#pragma unroll
    for (int dt = 0; dt < 4; ++dt) {
        bf16x8 v8; v8[0] = v.va[dt][0][0]; v8[1] = v.va[dt][0][1]; v8[2] = v.va[dt][0][2]; v8[3] = v.va[dt][0][3]; v8[4] = v.va[dt][1][0]; v8[5] = v.va[dt][1][1]; v8[6] = v.va[dt][1][2]; v8[7] = v.va[dt][1][3];
        st.o[dt] = mfma16(v8, pb, st.o[dt] * corr);
    }
}
template <class F>
__device__ __forceinline__ void attn_load(AttnKV& kv, const bf16_t* k0p, const bf16_t* k1p, const bf16_t* vb, int vds, int v0off, int v1off, F mbf, int fr, int g) {
    kv.a00 = *(const bf16x8*)k0p; kv.a01 = *(const bf16x8*)(k0p + 32); kv.a10 = *(const bf16x8*)k1p; kv.a11 = *(const bf16x8*)(k1p + 32);
#pragma unroll
    for (int dt = 0; dt < 4; ++dt) { const bf16_t* vp = vb + (size_t)(dt * 16 + fr) * vds; kv.va[dt][0] = *(const s16x4*)(vp + v0off); kv.va[dt][1] = *(const s16x4*)(vp + v1off); }
#pragma unroll
    for (int r = 0; r < 4; ++r) { kv.mb[r] = mbf(4 * g + r); kv.mb[4 + r] = mbf(16 + 4 * g + r); }
}
struct AttnKVn { bf16x8 a00, a01, a10, a11; s16x4 va[4][2]; };
struct AttnKn { bf16x8 a00, a01, a10, a11; };
struct AttnVn { s16x4 va[4][2]; };
struct AttnKVref { const AttnKn& k; const AttnVn& v; };
__device__ __forceinline__ void attn_load_n(AttnKVn& kv, const bf16_t* k0p, const bf16_t* k1p, const bf16_t* vb, int vds, int v0off, int v1off, int fr) {
    kv.a00 = *(const bf16x8*)k0p; kv.a01 = *(const bf16x8*)(k0p + 32); kv.a10 = *(const bf16x8*)k1p; kv.a11 = *(const bf16x8*)(k1p + 32);
#pragma unroll
    for (int dt = 0; dt < 4; ++dt) { const bf16_t* vp = vb + (size_t)(dt * 16 + fr) * vds; kv.va[dt][0] = *(const s16x4*)(vp + v0off); kv.va[dt][1] = *(const s16x4*)(vp + v1off); }
}
template <class KV>
__device__ __forceinline__ void attn_compute(const KV& kv, const float (&mbv)[8], bf16x8 q0, bf16x8 q1, AttnState& st) {
    f32x4 s0 = {0.f, 0.f, 0.f, 0.f}, s1 = {0.f, 0.f, 0.f, 0.f};
    s0 = mfma16(kv.a00, q0, s0); s0 = mfma16(kv.a01, q1, s0); s1 = mfma16(kv.a10, q0, s1); s1 = mfma16(kv.a11, q1, s1);
    float sc[8];
#pragma unroll
    for (int r = 0; r < 4; ++r) { sc[r] = s0[r] * 0.125f + mbv[r]; sc[4 + r] = s1[r] * 0.125f + mbv[4 + r]; }
    float mx = sc[0];
#pragma unroll
    for (int i = 1; i < 8; ++i) mx = fmaxf(mx, sc[i]);
    mx = xmax16(xmax32(mx));
    const float mn = fmaxf(st.m, mx), corr = __expf(st.m - mn); st.m = mn;
    float pp[8], ps = 0.f;
#pragma unroll
    for (int i = 0; i < 8; ++i) { pp[i] = __expf(sc[i] - mn); ps += pp[i]; }
    st.l = st.l * corr + ps;
    u32x4 pw; pw.x = pk2(pp[0], pp[1]); pw.y = pk2(pp[2], pp[3]); pw.z = pk2(pp[4], pp[5]); pw.w = pk2(pp[6], pp[7]);
    const bf16x8 pb = __builtin_bit_cast(bf16x8, pw);
#pragma unroll
    for (int dt = 0; dt < 4; ++dt) {
        bf16x8 v8; v8[0] = kv.va[dt][0][0]; v8[1] = kv.va[dt][0][1]; v8[2] = kv.va[dt][0][2]; v8[3] = kv.va[dt][0][3]; v8[4] = kv.va[dt][1][0]; v8[5] = kv.va[dt][1][1]; v8[6] = kv.va[dt][1][2]; v8[7] = kv.va[dt][1][3];
        st.o[dt] = mfma16(v8, pb, st.o[dt] * corr);
    }
}
template <int NCH, class LD, class CP>
__device__ __forceinline__ void attn_run(LD ld, CP cp) {
    AttnKV A, B; ld(0, A);
    int i = 0;
#pragma unroll 1
    for (; i + 1 < NCH; i += 2) {
        ld(i + 1, B);
        cp(i, A);
        ld(i + 2 < NCH ? i + 2 : NCH - 1, A);
        cp(i + 1, B);
    }
    if (NCH & 1) cp(NCH - 1, A);
}
__device__ __forceinline__ void attn_finish(AttnState& st, bf16_t* yrow  , int g) {
    float l = st.l; l += __shfl_xor(l, 16); l += __shfl_xor(l, 32);
    const float inv = 1.0f / l;
#pragma unroll
    for (int dt = 0; dt < 4; ++dt) { const f32x4 o = st.o[dt] * inv; u32x2 w; w.x = pk2(o[0], o[1]); w.y = pk2(o[2], o[3]); *(u32x2*)(yrow + dt * 16 + 4 * g) = w; }
}
__device__ __forceinline__ int clampi(int v, int lo, int hi) { return v < lo ? lo : (v > hi ? hi : v); }

__device__ __forceinline__ void na_task(const P& p, int task, int lane, float* ldsw  ) {
    const int fr = lane & 15, g = lane >> 4;
    const bf16_t* QK = (const bf16_t*)(p.ws + WS_NAQK); const bf16_t* VT = (const bf16_t*)(p.ws + WS_NAVT); bf16_t* Y = (bf16_t*)(p.ws + WS_A);
    if (task < 2048) {
        const int h = task & 7, r = (task >> 3) & 31, b = task >> 8;
        for (int i = lane; i < 465; i += 64) ldsw[i] = p.rpb[h * 465 + i];
        AttnState st[4];
        bf16_t* qlds = (bf16_t*)(ldsw + 512) + fr * 72 + g * 8;
        const size_t qrow0 = (size_t)b * TLAT + r * 64 + fr;
#pragma unroll
        for (int j = 0; j < 4; ++j) {
            st[j].m = -1e30f; st[j].l = 0.f;
#pragma unroll
            for (int dt = 0; dt < 4; ++dt) st[j].o[dt] = (f32x4){0.f, 0.f, 0.f, 0.f};
            const bf16_t* qp = QK + (qrow0 + j * 16) * 1024 + h * 64 + g * 8;
            *(bf16x8*)(qlds + j * 16 * 72) = *(const bf16x8*)qp; *(bf16x8*)(qlds + j * 16 * 72 + 32) = *(const bf16x8*)(qp + 32);
        }
        const int r0 = clampi(r - 4, 0, 24);
        const bf16_t* vb = VT + ((size_t)b * 512 + h * 64) * TT;
        const bf16_t* kbase = QK + 512 + h * 64 + g * 8;
        auto ldk = [&](int i, AttnKn& k) {
            const bf16_t* k0p = (i < 16) ? kbase + ((size_t)b * TLAT + (r0 + (i >> 1)) * 64 + (i & 1) * 32 + fr) * 1024 : kbase + ((size_t)MLAT + b * TCTX + (i - 16) * 32 + fr) * 1024;
            k.a00 = *(const bf16x8*)k0p; k.a01 = *(const bf16x8*)(k0p + 32); k.a10 = *(const bf16x8*)(k0p + 16 * 1024); k.a11 = *(const bf16x8*)(k0p + 16 * 1024 + 32);
        };
        auto ldv = [&](int i, AttnVn& v) {
            const int tok0 = (i < 16) ? (r0 + (i >> 1)) * 64 + (i & 1) * 32 : TLAT + (i - 16) * 32;
#pragma unroll
            for (int dt = 0; dt < 4; ++dt) { const bf16_t* vp = vb + (size_t)(dt * 16 + fr) * TT + tok0 + 4 * g; v.va[dt][0] = *(const s16x4*)vp; v.va[dt][1] = *(const s16x4*)(vp + 16); }
        };
        asm volatile("s_waitcnt lgkmcnt(0)" ::: "memory");
        AttnKn kc, kn; AttnVn vv; ldk(0, kc);
#pragma unroll 1
        for (int i = 0; i < 24; ++i) {
            ldk(i + 1 < 24 ? i + 1 : i, kn);
            ldv(i, vv);
            const int half = i & 1;
            const float* rp = ldsw + (r0 + (i >> 1) - r + 7) * 31;
#pragma unroll
            for (int j = 0; j < 4; ++j) {
                if (i < 16 && (half ? j == 0 : j == 3)) continue;
                float mbv[8];
                if (i < 16) {
                    const int qcol = j * 16 + fr, cst = clampi(qcol - 8, 0, 48);
#pragma unroll
                    for (int q8 = 0; q8 < 8; ++q8) { const int kk = (q8 < 4) ? 4 * g + q8 : 12 + 4 * g + q8; const int kcc = half * 32 + kk;
                        const bool ok = (kcc >= cst) && (kcc < cst + 16); const float bv = rp[clampi(kcc - qcol + 15, 0, 30)]; mbv[q8] = ok ? bv : -2e30f; }
                } else {
#pragma unroll
                    for (int q8 = 0; q8 < 8; ++q8) mbv[q8] = 0.f;
                }
                AttnKVn tmp; tmp.a00 = kc.a00; tmp.a01 = kc.a01; tmp.a10 = kc.a10; tmp.a11 = kc.a11;
#pragma unroll
                for (int dt = 0; dt < 4; ++dt) { tmp.va[dt][0] = vv.va[dt][0]; tmp.va[dt][1] = vv.va[dt][1]; }
                attn_compute(tmp, mbv, *(const bf16x8*)(qlds + j * 16 * 72), *(const bf16x8*)(qlds + j * 16 * 72 + 32), st[j]);
                __builtin_amdgcn_sched_barrier(0);
            }
            kc = kn;
        }
#pragma unroll
        for (int j = 0; j < 4; ++j) attn_finish(st[j], Y + (qrow0 + j * 16) * 1024 + h * 64, g);
    } else {
        AttnState st; st.m = -1e30f; st.l = 0.f;
#pragma unroll
        for (int dt = 0; dt < 4; ++dt) st.o[dt] = (f32x4){0.f, 0.f, 0.f, 0.f};
        const int t2 = task - 2048; const int h = t2 & 7, qb = (t2 >> 3) & 15, b = t2 >> 7;
        const size_t qrow = (size_t)MLAT + b * TCTX + qb * 16 + fr;
        const bf16_t* qp = QK + qrow * 1024 + h * 64 + g * 8;
        const bf16x8 q0 = *(const bf16x8*)qp, q1 = *(const bf16x8*)(qp + 32);
        const bf16_t* vb = VT + ((size_t)b * 512 + h * 64) * TT;
        const bf16_t* kbase = QK + 512 + h * 64 + g * 8;
        auto ld = [&](int c, AttnKV& kv) {
            const bf16_t* k0p = kbase + ((size_t)MLAT + b * TCTX + c * 32 + fr) * 1024;
            auto mb = [&](int) -> float { return 0.f; };
            attn_load(kv, k0p, k0p + 16 * 1024, vb, TT, TLAT + c * 32 + 4 * g, TLAT + c * 32 + 16 + 4 * g, mb, fr, g);
        };
        attn_run<8>(ld, [&](int, const AttnKV& kv) { attn_compute(kv, kv.mb, q0, q1, st); });
        attn_finish(st, Y + qrow * 1024 + h * 64, g);
    }
}
__device__ __forceinline__ void swa_task(const P& p, int task, int lane) {
    const int fr = lane & 15, g = lane >> 4;
    const bf16_t* Q = (const bf16_t*)(p.ws + WS_SWQ); const bf16_t* K = (const bf16_t*)(p.ws + WS_SWK); const bf16_t* VT = (const bf16_t*)(p.ws + WS_SWVT); bf16_t* Y = (bf16_t*)(p.ws + WS_A);
    const int g4 = task & 3, qb = (task >> 2) & 127, b = task >> 9;
    const int qt = qb * 16 + fr; const size_t qrow = (size_t)b * TLAT + qt;
    AttnState st[4]; bf16x8 q0[4], q1[4];
#pragma unroll
    for (int hh = 0; hh < 4; ++hh) {
        const int hq = g4 * 4 + hh;
        st[hh].m = p.sink[hq]; st[hh].l = (g == 0) ? 1.f : 0.f;
#pragma unroll
        for (int dt = 0; dt < 4; ++dt) st[hh].o[dt] = (f32x4){0.f, 0.f, 0.f, 0.f};
        const bf16_t* qp = Q + qrow * 1024 + hq * 64 + g * 8;
        q0[hh] = *(const bf16x8*)qp; q1[hh] = *(const bf16x8*)(qp + 32);
    }
    const bf16_t* vb = VT + ((size_t)b * 256 + g4 * 64) * TT;
    const bf16_t* kbase = K + g4 * 64 + g * 8;
    auto ld = [&](int i, AttnKV& kv) {
        if (i < 9) {
            const int kt0 = qb * 16 - 128 + 32 * i;
            const int kr0 = clampi(kt0 + fr, 0, TLAT - 1), kr1 = clampi(kt0 + 16 + fr, 0, TLAT - 1);
            const int v0 = clampi(kt0 + 4 * g, 0, TLAT - 4), v1 = clampi(kt0 + 16 + 4 * g, 0, TLAT - 4);
            auto mb = [&](int) -> float { return 0.f; };
            attn_load(kv, kbase + ((size_t)b * TLAT + kr0) * 256, kbase + ((size_t)b * TLAT + kr1) * 256, vb, TT, v0, v1, mb, fr, g);
        } else {
            const int c = i - 9;
            const bf16_t* k0p = kbase + ((size_t)MLAT + b * TCTX + c * 32 + fr) * 256;
            auto mb = [&](int) -> float { return 0.f; };
            attn_load(kv, k0p, k0p + 16 * 256, vb, TT, TLAT + c * 32 + 4 * g, TLAT + c * 32 + 16 + 4 * g, mb, fr, g);
        }
    };
    {
        AttnKV cur, nxt; ld(0, cur);
#pragma unroll 1
        for (int i = 0; i < 17; ++i) {
            const int in = (i + 1 < 17) ? i + 1 : i;
            ld(in, nxt);
            float mbv[8];
            {
                const int kt0 = qb * 16 - 128 + 32 * i;
#pragma unroll
                for (int r = 0; r < 8; ++r) { const int kk = (r < 4) ? 4 * g + r : 12 + 4 * g + r; const int kt = kt0 + kk; const int d = kt - qt;
                    const bool ok = (i >= 9) || ((kt >= 0) && (kt < TLAT) && (d <= 128) && (d >= -128)); mbv[r] = ok ? 0.f : -1e30f; }
            }
#pragma unroll
            for (int hh = 0; hh < 4; ++hh) attn_compute(cur, mbv, q0[hh], q1[hh], st[hh]);
            cur = nxt;
        }
    }
#pragma unroll
    for (int hh = 0; hh < 4; ++hh) attn_finish(st[hh], Y + qrow * 1024 + (g4 * 4 + hh) * 64, g);
}

constexpr int SW_KB = 4608, SW_STAGE = 4608 + 5120;
__device__ __forceinline__ void swa_block_task(const P& p, int task, unsigned char* sm, int tid) {
    const int wave = tid >> 6, lane = tid & 63, fr = lane & 15, g = lane >> 4;
    const bf16_t* Q = (const bf16_t*)(p.ws + WS_SWQ); const bf16_t* K = (const bf16_t*)(p.ws + WS_SWK); const bf16_t* VT = (const bf16_t*)(p.ws + WS_SWVT); bf16_t* Y = (bf16_t*)(p.ws + WS_A);
    const int g4 = task & 3, qblk = (task >> 2) & 15, b = task >> 6;
    const int Q0 = qblk * 128, qt = Q0 + wave * 16 + fr; const size_t qrow = (size_t)b * TLAT + qt;
    AttnState st[4]; bf16x8 q0[4], q1[4];
#pragma unroll
    for (int hh = 0; hh < 4; ++hh) {
        const int hq = g4 * 4 + hh;
        st[hh].m = p.sink[hq]; st[hh].l = (g == 0) ? 1.f : 0.f;
#pragma unroll
        for (int dt = 0; dt < 4; ++dt) st[hh].o[dt] = (f32x4){0.f, 0.f, 0.f, 0.f};
        const bf16_t* qp = Q + qrow * 1024 + hq * 64 + g * 8;
        q0[hh] = *(const bf16x8*)qp; q1[hh] = *(const bf16x8*)(qp + 32);
    }
    const int cw0 = Q0 >= 128 ? 0 : (128 - Q0) / 32, cw1 = (Q0 + 256 <= TLAT) ? 11 : (TLAT - 1 - (Q0 - 128)) / 32;
    const int nwin = cw1 - cw0 + 1, nch = nwin + 8;
    const bool isk = tid < 256; const int lr = isk ? (tid >> 3) : ((tid - 256) >> 2), lp = isk ? (tid & 7) : (tid & 3);
    auto gload = [&](int i) -> u32x4 {
        const int tok0 = (i < nwin) ? (Q0 - 128 + 32 * (cw0 + i)) : (TLAT + 32 * (i - nwin));
        if (isk) { const size_t row = (i < nwin) ? (size_t)b * TLAT + tok0 + lr : (size_t)MLAT + b * TCTX + 32 * (i - nwin) + lr;
            return *(const u32x4*)(K + row * 256 + g4 * 64 + lp * 8); }
        return *(const u32x4*)(VT + ((size_t)b * 256 + g4 * 64 + lr) * TT + tok0 + lp * 8);
    };
    auto lwrite = [&](int stage, const u32x4& v) {
        unsigned char* sb = sm + stage * SW_STAGE;
        if (isk) *(u32x4*)(sb + lr * 144 + lp * 16) = v; else *(u32x4*)(sb + SW_KB + lr * 80 + lp * 16) = v;
    };
    u32x4 R = gload(0);
    lwrite(0, R);
    if (nch > 1) R = gload(1);
    LDSBAR();
#pragma unroll 1
    for (int i = 0; i < nch; ++i) {
        const unsigned char* sb = sm + (i & 1) * SW_STAGE;
        const bool win = i < nwin;
        const int kt0 = Q0 - 128 + 32 * (cw0 + i);
        const int qt0 = Q0 + wave * 16;
        const bool need = !win || (kt0 + 31 >= qt0 - 128 && kt0 <= qt0 + 15 + 128);
        if (need) {
            AttnKVn kv;
            { const unsigned char* kp = sb + fr * 144 + g * 16;
              kv.a00 = *(const bf16x8*)kp; kv.a01 = *(const bf16x8*)(kp + 64); kv.a10 = *(const bf16x8*)(kp + 16 * 144); kv.a11 = *(const bf16x8*)(kp + 16 * 144 + 64);
#pragma unroll
              for (int dt = 0; dt < 4; ++dt) { const unsigned char* vp = sb + SW_KB + (dt * 16 + fr) * 80 + g * 8; kv.va[dt][0] = *(const s16x4*)vp; kv.va[dt][1] = *(const s16x4*)(vp + 32); } }
            float mbv[8];
#pragma unroll
            for (int r = 0; r < 8; ++r) { const int kk = (r < 4) ? 4 * g + r : 12 + 4 * g + r; const int d = kt0 + kk - qt; mbv[r] = (!win || (d <= 128 && d >= -128)) ? 0.f : -1e30f; }
#pragma unroll
            for (int hh = 0; hh < 4; ++hh) attn_compute(kv, mbv, q0[hh], q1[hh], st[hh]);
        }
        if (i + 1 < nch) lwrite((i + 1) & 1, R);
        if (i + 2 < nch) R = gload(i + 2);
        LDSBAR();
    }
#pragma unroll
    for (int hh = 0; hh < 4; ++hh) attn_finish(st[hh], Y + qrow * 1024 + (g4 * 4 + hh) * 64, g);
}

__device__ __forceinline__ void dn_conv_token4(const P& p, int m0, int lane) {
    const bf16_t* PRE = (const bf16_t*)(p.ws + WS_DNPRE);
    int s0, s1;
    if (m0 < MLAT) { s0 = m0 & ~2047; s1 = s0 + 2048; } else { s0 = MLAT + ((m0 - MLAT) & ~255); s1 = s0 + 256; }
#pragma unroll 1
    for (int cgp = 0; cgp < 3; ++cgp) {
        const int col = cgp * 512 + lane * 8;
        f32x4 w[5][2];
#pragma unroll
        for (int j = 0; j < 5; ++j) { w[j][0] = *(const f32x4*)(p.conv_w + j * 1536 + col); w[j][1] = *(const f32x4*)(p.conv_w + j * 1536 + col + 4); }
        u32x4 xr[8];
#pragma unroll
        for (int r = 0; r < 8; ++r) { const int mm = m0 + r - 2; xr[r] = (mm >= s0 && mm < s1) ? *(const u32x4*)(PRE + (size_t)mm * 1536 + col) : (u32x4){0u, 0u, 0u, 0u}; }
        bf16_t* dbase = (bf16_t*)(p.ws + (cgp == 0 ? WS_QN : (cgp == 1 ? WS_KN : WS_VV))) + lane * 8;
#pragma unroll
        for (int t = 0; t < 4; ++t) {
            float acc[8];
#pragma unroll
            for (int i = 0; i < 8; ++i) acc[i] = 0.f;
#pragma unroll
            for (int j = 0; j < 5; ++j) { const u32x4 xv = xr[t + j];
                acc[0] += bflo(xv.x) * w[j][0][0]; acc[1] += bfhi(xv.x) * w[j][0][1]; acc[2] += bflo(xv.y) * w[j][0][2]; acc[3] += bfhi(xv.y) * w[j][0][3];
                acc[4] += bflo(xv.z) * w[j][1][0]; acc[5] += bfhi(xv.z) * w[j][1][1]; acc[6] += bflo(xv.w) * w[j][1][2]; acc[7] += bfhi(xv.w) * w[j][1][3]; }
            float ss = 0.f;
#pragma unroll
            for (int i = 0; i < 8; ++i) { acc[i] = siluf(acc[i]); ss += acc[i] * acc[i]; }
            if (cgp < 2) {
                ss += __shfl_xor(ss, 1); ss += __shfl_xor(ss, 2); ss += __shfl_xor(ss, 4); ss += __shfl_xor(ss, 8);
                const float rn = 1.0f / sqrtf(ss + EPS);
#pragma unroll
                for (int i = 0; i < 8; ++i) acc[i] *= rn;
            }
            u32x4 o; o.x = pk2(acc[0], acc[1]); o.y = pk2(acc[2], acc[3]); o.z = pk2(acc[4], acc[5]); o.w = pk2(acc[6], acc[7]);
            *(u32x4*)(dbase + (size_t)(m0 + t) * 512) = o;
        }
    }
    {
        const int m = m0 + (lane >> 4), idx = lane & 15;
        const float a = ((const float*)(p.ws + WS_AB))[(size_t)m * 16 + idx];
        float r;
        if (idx < 8) { const float xx = a + p.dt_bias[idx]; const float sp = fmaxf(xx, 0.f) + log1pf(__expf(-fabsf(xx))); r = -__expf(p.a_log[idx]) * sp; }
        else r = 1.f / (1.f + __expf(-a));
        ((float*)(p.ws + WS_GB))[(size_t)m * 16 + idx] = r;
    }
}

template <int DIR>
__device__ __forceinline__ void dn_solve(const P& p, int task, int m0, int h, int t2, const bf16_t* kn_s, const bf16_t* v_s, const float* gc, const float* be, float* L) {
    float x[64];
    if (t2 < 128) {
#pragma unroll
        for (int cp = 0; cp < 64; ++cp) { const int tok = DIR ? 63 - cp : cp; x[cp] = bf2f(v_s[tok * 136 + t2]) * be[cp]; }
    } else {
        const int k = t2 - 128;
#pragma unroll
        for (int cp = 0; cp < 64; ++cp) { const int tok = DIR ? 63 - cp : cp; x[cp] = bf2f(kn_s[tok * 136 + k]) * be[cp] * __expf(gc[cp]); }
    }
#pragma unroll
    for (int cp = 1; cp < 64; ++cp) {
        float a0 = 0.f, a1 = 0.f, a2 = 0.f, a3 = 0.f;
#pragma unroll
        for (int s4 = 0; s4 < cp; s4 += 4) { const f32x4 l4 = *(const f32x4*)(L + cp * 64 + s4); a0 += l4[0] * x[s4]; a1 += l4[1] * x[s4 + 1]; a2 += l4[2] * x[s4 + 2]; a3 += l4[3] * x[s4 + 3]; }
        x[cp] -= (a0 + a1) + (a2 + a3);
    }
    const size_t dt = (size_t)task * 2 + DIR;
    if (t2 < 128) {
        bf16_t* dst = (bf16_t*)(p.ws + WS_UT) + dt * 8192 + t2 * 64;
#pragma unroll
        for (int t8 = 0; t8 < 64; t8 += 8) {
            u32x4 o;
            o.x = pk2(x[DIR ? 63 - t8 : t8], x[DIR ? 62 - t8 : t8 + 1]); o.y = pk2(x[DIR ? 61 - t8 : t8 + 2], x[DIR ? 60 - t8 : t8 + 3]);
            o.z = pk2(x[DIR ? 59 - t8 : t8 + 4], x[DIR ? 58 - t8 : t8 + 5]); o.w = pk2(x[DIR ? 57 - t8 : t8 + 6], x[DIR ? 56 - t8 : t8 + 7]);
            *(u32x4*)(dst + t8) = o;
        }
    }
    __syncthreads();
    bf16_t* wt = (bf16_t*)L;
    if (t2 >= 128) {
        const int k = t2 - 128;
#pragma unroll
        for (int cp = 0; cp < 64; ++cp) { const int tok = DIR ? 63 - cp : cp; wt[tok * 128 + k] = (bf16_t)f2bf(-x[cp]); }
    }
    __syncthreads();
    {
        u32x4* dst = (u32x4*)((bf16_t*)(p.ws + WS_NEGW) + dt * 8192);
#pragma unroll
        for (int i = 0; i < 4; ++i) dst[t2 + 256 * i] = *(const u32x4*)(wt + (t2 + 256 * i) * 8);
    }
}

__device__ __forceinline__ void dn_prep_task(const P& p, int task, unsigned char* sm, int tid) {
    const int h = task & 3, bc = task >> 2, ck = bc % 36, b = bc / 36;
    const int m0 = ck < 4 ? MLAT + b * TCTX + ck * 64 : b * TLAT + (ck - 4) * 64;
    const int wave = tid >> 6, lane = tid & 63, dir = tid >> 8, t2 = tid & 255;
    bf16_t* kn_s = (bf16_t*)sm;
    bf16_t* qn_s = kn_s + 64 * 136;
    float* KK = (float*)(sm + 34816);
    float* QK = KK + 64 * 65;
    float* gc_s = (float*)(sm + 68096);
    float* be_s = gc_s + 128;
    float* Ls = be_s + 128;
    bf16_t* v_s = (bf16_t*)(sm + 101888);
    {
        const int r = tid >> 3, c16 = (tid & 7) * 16;
        const bf16_t* ks = (const bf16_t*)(p.ws + WS_KN) + (size_t)(m0 + r) * 512 + h * 128 + c16;
        const bf16_t* qs = (const bf16_t*)(p.ws + WS_QN) + (size_t)(m0 + r) * 512 + h * 128 + c16;
        *(u32x4*)(kn_s + r * 136 + c16) = *(const u32x4*)ks; *(u32x4*)(kn_s + r * 136 + c16 + 8) = *(const u32x4*)(ks + 8);
        *(u32x4*)(qn_s + r * 136 + c16) = *(const u32x4*)qs; *(u32x4*)(qn_s + r * 136 + c16 + 8) = *(const u32x4*)(qs + 8);
        const bf16_t* vs = (const bf16_t*)(p.ws + WS_VV) + (size_t)(m0 + r) * 512 + h * 128 + c16;
        *(u32x4*)(v_s + r * 136 + c16) = *(const u32x4*)vs; *(u32x4*)(v_s + r * 136 + c16 + 8) = *(const u32x4*)(vs + 8);
    }
    if (t2 < 64) {
        const int tok = dir ? 63 - t2 : t2;
        const float* gb = (const float*)(p.ws + WS_GB) + (size_t)(m0 + tok) * 16;
        float gv = gb[dir * 4 + h]; const float bv = gb[8 + dir * 4 + h];
#pragma unroll
        for (int o = 1; o < 64; o <<= 1) { const float v = __shfl_up(gv, o); if (lane >= o) gv += v; }
        gc_s[dir * 64 + t2] = gv; be_s[dir * 64 + t2] = bv;
    }
    __syncthreads();
    {
        const int which = wave >> 2, it = wave & 3, fr = lane & 15, g = lane >> 4;
        const bf16_t* As = which ? qn_s : kn_s; float* Out = which ? QK : KK;
        bf16x8 a[4];
#pragma unroll
        for (int ks = 0; ks < 4; ++ks) a[ks] = *(const bf16x8*)(As + (it * 16 + fr) * 136 + ks * 32 + g * 8);
#pragma unroll
        for (int jt = 0; jt < 4; ++jt) {
            f32x4 acc = {0.f, 0.f, 0.f, 0.f};
#pragma unroll
            for (int ks = 0; ks < 4; ++ks) { const bf16x8 bb = *(const bf16x8*)(kn_s + (jt * 16 + fr) * 136 + ks * 32 + g * 8); acc = mfma16(a[ks], bb, acc); }
#pragma unroll
            for (int r = 0; r < 4; ++r) Out[(it * 16 + 4 * g + r) * 65 + jt * 16 + fr] = acc[r];
        }
    }
    __syncthreads();
    const float* gc = gc_s + dir * 64; const float* be = be_s + dir * 64; float* L = Ls + dir * 4096;
    const size_t dt = (size_t)task * 2 + dir;
    {
        const int cp = t2 >> 2, s0 = (t2 & 3) * 16; const int ctok = dir ? 63 - cp : cp; const float gcc = gc[cp], bec = be[cp];
#pragma unroll
        for (int i = 0; i < 16; ++i) { const int sp = s0 + i, stok = dir ? 63 - sp : sp; float v = 0.f; if (cp > sp) v = bec * KK[ctok * 65 + stok] * __expf(gcc - gc[sp]); L[cp * 64 + sp] = v; }
        const int c = t2 >> 2, c_p = dir ? 63 - c : c; const float gq = gc[c_p];
        float qv[16];
#pragma unroll
        for (int i = 0; i < 16; ++i) { const int s = s0 + i, s_p = dir ? 63 - s : s; qv[i] = (c_p >= s_p) ? QK[c * 65 + s] * SCALE_DK * __expf(gq - gc[s_p]) : 0.f; }
        bf16_t* qd = (bf16_t*)(p.ws + WS_QKC) + dt * 4096 + c * 64 + s0;
        u32x4 o0, o1; o0.x = pk2(qv[0], qv[1]); o0.y = pk2(qv[2], qv[3]); o0.z = pk2(qv[4], qv[5]); o0.w = pk2(qv[6], qv[7]);
        o1.x = pk2(qv[8], qv[9]); o1.y = pk2(qv[10], qv[11]); o1.z = pk2(qv[12], qv[13]); o1.w = pk2(qv[14], qv[15]);
        *(u32x4*)qd = o0; *(u32x4*)(qd + 8) = o1;
        if (t2 < 64) { const int cc = t2, ccp = dir ? 63 - cc : cc; float* rs = (float*)(p.ws + WS_RSCS) + dt * 256;
            rs[cc] = SCALE_DK * __expf(gc[ccp]); rs[64 + cc] = __expf(gc[63] - gc[ccp]); if (t2 == 0) rs[128] = __expf(gc[63]); }
    }
    {
        const int k = tid >> 2, tk0 = (tid & 3) * 16; float kv[16];
#pragma unroll
        for (int i = 0; i < 16; ++i) kv[i] = bf2f(kn_s[(tk0 + i) * 136 + k]);
        bf16_t* kd = (bf16_t*)(p.ws + WS_KNT) + (size_t)task * 8192 + k * 64 + tk0;
        u32x4 o0, o1; o0.x = pk2(kv[0], kv[1]); o0.y = pk2(kv[2], kv[3]); o0.z = pk2(kv[4], kv[5]); o0.w = pk2(kv[6], kv[7]);
        o1.x = pk2(kv[8], kv[9]); o1.y = pk2(kv[10], kv[11]); o1.z = pk2(kv[12], kv[13]); o1.w = pk2(kv[14], kv[15]);
        *(u32x4*)kd = o0; *(u32x4*)(kd + 8) = o1;
    }
    __syncthreads();
    if (dir == 0) dn_solve<0>(p, task, m0, h, t2, kn_s, v_s, gc, be, L); else dn_solve<1>(p, task, m0, h, t2, kn_s, v_s, gc, be, L);
    __syncthreads();
}

struct ScanRegs { u32x4 a[2], b[2], c, d[2], e, f; };
constexpr int SC_QN = 17408, SC_QK = 34816, SC_KNT = 44032, SC_UT = 62464, SC_RS = 67072, SC_STAGE = 67648, SC_BASE = 18432;
__device__ __forceinline__ int scan_m0(int step, int b, int dir, int& task_out, int h) {
    const int ck = dir ? (step < 4 ? 3 - step : 39 - step) : step;
    task_out = (b * 36 + ck) * 4 + h;
    return ck < 4 ? MLAT + b * TCTX + ck * 64 : b * TLAT + (ck - 4) * 64;
}
__device__ __forceinline__ void scan_gload(ScanRegs& R, const P& p, int step, int b, int h, int dir, int es, int t) {
    int task; const int m0 = scan_m0(step, b, dir, task, h); const size_t dt = (size_t)task * 2 + dir;
    const u32x4* negw = (const u32x4*)((const bf16_t*)(p.ws + WS_NEGW) + dt * 8192);
    const u32x4* qk = (const u32x4*)((const bf16_t*)(p.ws + WS_QKC) + dt * 4096);
    const u32x4* knT = (const u32x4*)((const bf16_t*)(p.ws + WS_KNT) + (size_t)task * 8192);
    const u32x4* uT = (const u32x4*)((const bf16_t*)(p.ws + WS_UT) + dt * 8192 + es * 32 * 64);
    const u32x4* rscs = (const u32x4*)((const float*)(p.ws + WS_RSCS) + dt * 256);
    const bf16_t* qn = (const bf16_t*)(p.ws + WS_QN) + (size_t)m0 * 512 + h * 128;
#pragma unroll
    for (int i = 0; i < 2; ++i) { const int pp = t + 512 * i; R.a[i] = negw[pp]; R.b[i] = *(const u32x4*)(qn + (size_t)(pp >> 4) * 512 + (pp & 15) * 8); R.d[i] = knT[pp]; }
    R.c = qk[t];
    R.e = uT[t & 255];
    R.f = rscs[t < 33 ? t : 0];
}
__device__ __forceinline__ void scan_lwrite(unsigned char* sb, const ScanRegs& R, int t) {
#pragma unroll
    for (int i = 0; i < 2; ++i) { const int pp = t + 512 * i;
        *(u32x4*)(sb + (pp >> 4) * 272 + (pp & 15) * 16) = R.a[i];
        *(u32x4*)(sb + SC_QN + (pp >> 4) * 272 + (pp & 15) * 16) = R.b[i];
        *(u32x4*)(sb + SC_KNT + (pp >> 3) * 144 + (pp & 7) * 16) = R.d[i]; }
    *(u32x4*)(sb + SC_QK + (t >> 3) * 144 + (t & 7) * 16) = R.c;
    if (t < 256) *(u32x4*)(sb + SC_UT + (t >> 3) * 144 + (t & 7) * 16) = R.e;
    if (t < 33) *(u32x4*)(sb + SC_RS + t * 16) = R.f;
}
__device__ __forceinline__ void dn_scan_task(const P& p, int st, unsigned char* sm, int tid) {
    const int combo = (st & 7) + 8 * (st >> 5), es = (st >> 3) & 3;
    const int dir = combo & 1, h = (combo >> 1) & 3, b = combo >> 3;
    const int wave = tid >> 6, lane = tid & 63, fr = lane & 15, g = lane >> 4;
    bf16_t* ST = (bf16_t*)sm;
    bf16_t* VT = ST + 32 * 136;
    bf16_t* VS = VT + 32 * 72;
    const int ct = wave & 3, en = wave >> 2, e0 = es * 32 + en * 16, kt0 = 2 * (wave & 3);
    f32x4 S0 = {0.f, 0.f, 0.f, 0.f}, S1 = {0.f, 0.f, 0.f, 0.f};
    for (int i = tid; i < 32 * 136 / 2; i += NTHREADS) ((unsigned*)ST)[i] = 0u;
    float* O = (float*)(p.ws + (dir ? WS_KN : WS_O));
    ScanRegs R;
    scan_gload(R, p, 0, b, h, dir, es, tid);
    scan_lwrite(sm + SC_BASE, R, tid);
    scan_gload(R, p, 1, b, h, dir, es, tid);
    LDSBAR();
#pragma unroll 1
    for (int step = 0; step < 36; ++step) {
        const unsigned char* sb = sm + SC_BASE + (step & 1) * SC_STAGE;
        int task_; const int m0 = scan_m0(step, b, dir, task_, h);
        f32x4 vn, oq = {0.f, 0.f, 0.f, 0.f};
        { const s16x4 u4 = *(const s16x4*)(sb + SC_UT + (en * 16 + fr) * 144 + (ct * 16 + 4 * g) * 2);
#pragma unroll
          for (int r = 0; r < 4; ++r) vn[r] = bf2f((unsigned short)u4[r]); }
        const f32x4 rs = *(const f32x4*)(sb + SC_RS + (ct * 16 + 4 * g) * 4), cs = *(const f32x4*)(sb + SC_RS + 256 + (ct * 16 + 4 * g) * 4);
        const float gl = *(const float*)(sb + SC_RS + 512);
#pragma unroll
        for (int ks = 0; ks < 4; ++ks) {
            const bf16x8 bs = *(const bf16x8*)(ST + (en * 16 + fr) * 136 + ks * 32 + g * 8);
            const bf16x8 aw = *(const bf16x8*)(sb + (ct * 16 + fr) * 272 + ks * 64 + g * 16), aq = *(const bf16x8*)(sb + SC_QN + (ct * 16 + fr) * 272 + ks * 64 + g * 16);
            vn = mfma16(aw, bs, vn); oq = mfma16(aq, bs, oq); }
        oq = oq * rs;
        { u32x2 w; w.x = pk2(vn[0], vn[1]); w.y = pk2(vn[2], vn[3]); *(u32x2*)(VT + (en * 16 + fr) * 72 + ct * 16 + 4 * g) = w;
          const f32x4 vs = vn * cs; w.x = pk2(vs[0], vs[1]); w.y = pk2(vs[2], vs[3]); *(u32x2*)(VS + (en * 16 + fr) * 72 + ct * 16 + 4 * g) = w; }
        LDSBAR();
        S0 = S0 * gl; S1 = S1 * gl;
#pragma unroll
        for (int ks = 0; ks < 2; ++ks) {
            const bf16x8 bv = *(const bf16x8*)(VT + (en * 16 + fr) * 72 + ks * 32 + g * 8);
            const bf16x8 bv2 = *(const bf16x8*)(VS + (en * 16 + fr) * 72 + ks * 32 + g * 8);
            const bf16x8 aqk = *(const bf16x8*)(sb + SC_QK + (ct * 16 + fr) * 144 + ks * 64 + g * 16);
            const bf16x8 ak0 = *(const bf16x8*)(sb + SC_KNT + (kt0 * 16 + fr) * 144 + ks * 64 + g * 16), ak1 = *(const bf16x8*)(sb + SC_KNT + ((kt0 + 1) * 16 + fr) * 144 + ks * 64 + g * 16);
            oq = mfma16(aqk, bv, oq); S0 = mfma16(ak0, bv2, S0); S1 = mfma16(ak1, bv2, S1);
        }
#pragma unroll
        for (int r = 0; r < 4; ++r) O[(size_t)(m0 + ct * 16 + 4 * g + r) * 512 + h * 128 + e0 + fr] = oq[r];
        { u32x2 w; w.x = pk2(S0[0], S0[1]); w.y = pk2(S0[2], S0[3]); *(u32x2*)(ST + (en * 16 + fr) * 136 + kt0 * 16 + 4 * g) = w;
          w.x = pk2(S1[0], S1[1]); w.y = pk2(S1[2], S1[3]); *(u32x2*)(ST + (en * 16 + fr) * 136 + (kt0 + 1) * 16 + 4 * g) = w; }
        if (step + 1 < 36) scan_lwrite(sm + SC_BASE + ((step + 1) & 1) * SC_STAGE, R, tid);
        if (step + 2 < 36) scan_gload(R, p, step + 2, b, h, dir, es, tid);
        LDSBAR();
    }
    __syncthreads();
}
__device__ __forceinline__ void dn_comb_token(const P& p, int m, int lane) {
    const float* o = (const float*)(p.ws + WS_O) + (size_t)m * 512 + lane * 8;
    const float* o2 = (const float*)(p.ws + WS_KN) + (size_t)m * 512 + lane * 8;
    const f32x4 a0 = *(const f32x4*)o + *(const f32x4*)o2, a1 = *(const f32x4*)(o + 4) + *(const f32x4*)(o2 + 4);
    float ss = a0[0] * a0[0] + a0[1] * a0[1] + a0[2] * a0[2] + a0[3] * a0[3] + a1[0] * a1[0] + a1[1] * a1[1] + a1[2] * a1[2] + a1[3] * a1[3];
    ss += __shfl_xor(ss, 1); ss += __shfl_xor(ss, 2); ss += __shfl_xor(ss, 4); ss += __shfl_xor(ss, 8);
    const float rn = 1.0f / sqrtf(ss * (1.f / 128.f) + EPS);
    const int e = (lane & 15) * 8;
    const f32x4 w0 = *(const f32x4*)(p.dn_norm_w + e), w1 = *(const f32x4*)(p.dn_norm_w + e + 4);
    const u32x4 zv = *(const u32x4*)((const bf16_t*)(p.ws + WS_Z) + (size_t)m * 512 + lane * 8);
    float y[8];
    y[0] = a0[0] * rn * w0[0] * siluf(bflo(zv.x)); y[1] = a0[1] * rn * w0[1] * siluf(bfhi(zv.x)); y[2] = a0[2] * rn * w0[2] * siluf(bflo(zv.y)); y[3] = a0[3] * rn * w0[3] * siluf(bfhi(zv.y));
    y[4] = a1[0] * rn * w1[0] * siluf(bflo(zv.z)); y[5] = a1[1] * rn * w1[1] * siluf(bfhi(zv.z)); y[6] = a1[2] * rn * w1[2] * siluf(bflo(zv.w)); y[7] = a1[3] * rn * w1[3] * siluf(bfhi(zv.w));
    u32x4 ov; ov.x = pk2(y[0], y[1]); ov.y = pk2(y[2], y[3]); ov.z = pk2(y[4], y[5]); ov.w = pk2(y[6], y[7]);
    *(u32x4*)((bf16_t*)(p.ws + WS_A) + (size_t)m * 1024 + 512 + lane * 8) = ov;
}

__device__ __forceinline__ void dn_comb_token2(const P& p, int m0, int m1, int lane) {
    const int mm[2] = {m0, m1};
    f32x4 a0[2], a1[2]; u32x4 zv[2];
#pragma unroll
    for (int k = 0; k < 2; ++k) {
        const float* o = (const float*)(p.ws + WS_O) + (size_t)mm[k] * 512 + lane * 8;
        const float* o2 = (const float*)(p.ws + WS_KN) + (size_t)mm[k] * 512 + lane * 8;
        a0[k] = *(const f32x4*)o + *(const f32x4*)o2; a1[k] = *(const f32x4*)(o + 4) + *(const f32x4*)(o2 + 4);
        zv[k] = *(const u32x4*)((const bf16_t*)(p.ws + WS_Z) + (size_t)mm[k] * 512 + lane * 8);
    }
    const int e = (lane & 15) * 8;
    const f32x4 w0 = *(const f32x4*)(p.dn_norm_w + e), w1 = *(const f32x4*)(p.dn_norm_w + e + 4);
#pragma unroll
    for (int k = 0; k < 2; ++k) {
        float ss = a0[k][0] * a0[k][0] + a0[k][1] * a0[k][1] + a0[k][2] * a0[k][2] + a0[k][3] * a0[k][3] + a1[k][0] * a1[k][0] + a1[k][1] * a1[k][1] + a1[k][2] * a1[k][2] + a1[k][3] * a1[k][3];
        ss += __shfl_xor(ss, 1); ss += __shfl_xor(ss, 2); ss += __shfl_xor(ss, 4); ss += __shfl_xor(ss, 8);
        const float rn = 1.0f / sqrtf(ss * (1.f / 128.f) + EPS);
        float y[8];
        y[0] = a0[k][0] * rn * w0[0] * siluf(bflo(zv[k].x)); y[1] = a0[k][1] * rn * w0[1] * siluf(bfhi(zv[k].x)); y[2] = a0[k][2] * rn * w0[2] * siluf(bflo(zv[k].y)); y[3] = a0[k][3] * rn * w0[3] * siluf(bfhi(zv[k].y));
        y[4] = a1[k][0] * rn * w1[0] * siluf(bflo(zv[k].z)); y[5] = a1[k][1] * rn * w1[1] * siluf(bfhi(zv[k].z)); y[6] = a1[k][2] * rn * w1[2] * siluf(bflo(zv[k].w)); y[7] = a1[k][3] * rn * w1[3] * siluf(bfhi(zv[k].w));
        u32x4 ov; ov.x = pk2(y[0], y[1]); ov.y = pk2(y[2], y[3]); ov.z = pk2(y[4], y[5]); ov.w = pk2(y[6], y[7]);
        if (k == 0 || m1 != m0) *(u32x4*)((bf16_t*)(p.ws + WS_A) + (size_t)mm[k] * 1024 + 512 + lane * 8) = ov;
    }
}
#define LAS __attribute__((address_space(3)))
#define XB_TMO      128
#define XB_XCNT(j)  (256  + 64 * (j))
#define XB_XSUB(j)  (1280 + 64 * (j))
#define XB_XGEN(j)  (2304 + 64 * (j))
#define XB_TOP      3328
#define XB_TOPGEN   3392
#define XCD_BAR_WORDS 3456
#define XB_SPIN_CAP (1u << 18)

__device__ __forceinline__ unsigned xb_ld(unsigned* p)              { return __hip_atomic_load(p, __ATOMIC_RELAXED, __HIP_MEMORY_SCOPE_AGENT); }
__device__ __forceinline__ unsigned xb_add(unsigned* p, unsigned v) { return __hip_atomic_fetch_add(p, v, __ATOMIC_RELAXED, __HIP_MEMORY_SCOPE_AGENT); }
__device__ __forceinline__ unsigned xb_xcc_id() { return (unsigned)__builtin_amdgcn_s_getreg((3 << 11) | 20) & 0xFu; }
#define XB_SPIN(cond, bar) do { unsigned _sp = 0; while (cond) { __builtin_amdgcn_s_sleep(1); \
    if ((++_sp & 255u) == 0u) { if (xb_ld(&(bar)[XB_TMO])) break; if (_sp > XB_SPIN_CAP) { atomicAdd(&(bar)[XB_TMO], 1u); break; } } } } while (0)

struct XcdBarrier {
    unsigned* bar; unsigned x;
    volatile LAS unsigned* st;
};

__device__ __forceinline__ XcdBarrier xcd_barrier_post(unsigned* bar, volatile LAS unsigned* st) {
    XcdBarrier b; b.bar = bar; b.x = xb_xcc_id(); b.st = st;
    if (threadIdx.x == 0) (void)xb_add(&bar[XB_XCNT(b.x)], 1u);
    return b;
}
__device__ __forceinline__ void xcd_barrier_complete(unsigned* bar, unsigned x, unsigned& nloc, unsigned& nx) {
    const unsigned G = gridDim.x * gridDim.y * gridDim.z;
    unsigned sum, cnt, mine, sp = 0u;
    for (;;) {
        sum = 0u; cnt = 0u; mine = 0u;
#pragma unroll
        for (unsigned j = 0; j < 16; ++j) { const unsigned c = xb_ld(&bar[XB_XCNT(j)]); sum += c; cnt += (c > 0u) ? 1u : 0u; mine = (j == x) ? c : mine; }
        if (sum == G) break;
        __builtin_amdgcn_s_sleep(1);
        if ((++sp & 255u) == 0u) { if (xb_ld(&bar[XB_TMO])) break; if (sp > XB_SPIN_CAP) { atomicAdd(&bar[XB_TMO], 1u); break; } }
    }
    nloc = mine > 0u ? mine : 1u; nx = cnt > 0u ? cnt : 1u;
}

__device__ __forceinline__ void xcd_barrier(const XcdBarrier& b) {
    asm volatile("s_waitcnt vmcnt(0)" ::: "memory");
    __syncthreads();
    if (threadIdx.x == 0) {
        unsigned* bar = b.bar;
        __builtin_amdgcn_s_waitcnt(0);
        unsigned nloc = b.st[0], nx = b.st[1];
        if (nloc == 0u) { xcd_barrier_complete(bar, b.x, nloc, nx); b.st[0] = nloc; b.st[1] = nx; }
        const unsigned old = xb_add(&bar[XB_XSUB(b.x)], 1u);
        const unsigned gen = old / nloc;
        if (old + 1u == (gen + 1u) * nloc) {
            __builtin_amdgcn_fence(__ATOMIC_RELEASE, "agent");
            asm volatile("s_waitcnt vmcnt(0)" ::: "memory");
            const unsigned og = xb_add(&bar[XB_TOP], 1u);
            const unsigned tg = og / nx;
            if (og + 1u == (tg + 1u) * nx) xb_add(&bar[XB_TOPGEN], 1u);
            else XB_SPIN(xb_ld(&bar[XB_TOPGEN]) == tg, bar);
            __builtin_amdgcn_fence(__ATOMIC_ACQUIRE, "agent");
            xb_add(&bar[XB_XGEN(b.x)], 1u);
            asm volatile("s_waitcnt vmcnt(0)" ::: "memory");
        } else {
            XB_SPIN(xb_ld(&bar[XB_XGEN(b.x)]) == gen, bar);
            __builtin_amdgcn_fence(__ATOMIC_ACQUIRE, "agent");
            asm volatile("s_waitcnt vmcnt(0)" ::: "memory");
        }
    }
    __syncthreads();
}

#ifndef SKIPMASK
#define SKIPMASK 0
#endif
#define RUN(k) (!((SKIPMASK) & (1 << (k))))
#ifndef REPMASK
#define REPMASK 0
#endif
#define REP(k) for (int rep_ = 0; rep_ < (((REPMASK) >> (k)) & 1) + 1; ++rep_)
__global__ void __launch_bounds__(NTHREADS) mega_fwd(P p) {
    extern __shared__ __attribute__((aligned(16))) unsigned char lds[];
    cg::grid_group grid = cg::this_grid();
    const int G = gridDim.x, ngw = G * 8;
    P q;
    int tidl = threadIdx.x, lane = 0, wave = 0, gw = 0;
#define PH() do { unsigned zo_ = 0u; asm volatile("" : "+v"(zo_), "+v"(tidl)); zo_ = __builtin_amdgcn_readfirstlane(zo_); \
        typedef const __attribute__((address_space(4))) P* KP_; KP_ kp_ = (KP_)((const __attribute__((address_space(4))) char*)__builtin_amdgcn_kernarg_segment_ptr() + zo_); \
        q.x = kp_->x; q.c = kp_->c; q.ctx = kp_->ctx; q.c_ctx = kp_->c_ctx; q.ada_w = kp_->ada_w; q.ada_b = kp_->ada_b; q.norm_g = kp_->norm_g; q.w_up = kp_->w_up; q.w_dn = kp_->w_dn; q.e_in = kp_->e_in; \
        q.e_out = kp_->e_out; q.rpb = kp_->rpb; q.conv_w = kp_->conv_w; q.a_log = kp_->a_log; q.dt_bias = kp_->dt_bias; q.dn_norm_w = kp_->dn_norm_w; q.o_in = kp_->o_in; q.o_out = kp_->o_out; q.sink = kp_->sink; q.fin_g = kp_->fin_g; \
        q.out = kp_->out; q.ws = kp_->ws; lane = tidl & 63; wave = __builtin_amdgcn_readfirstlane(tidl >> 6); gw = blockIdx.x * 8 + wave; } while (0)
#define GSYNC() do { xcd_barrier(bar); if ((REPMASK) & (1 << 20)) xcd_barrier(bar); } while (0)
#define LDSL ((PG8_LAS unsigned char*)lds)
#define HLAT (q.out)
#define HCTX ((float*)(q.ws + WS_HCTX))
#define ABUF ((bf16_t*)(q.ws + WS_A))
#define MODP ((const float*)(q.ws + WS_MOD))

    volatile LAS unsigned* MISC = (volatile LAS unsigned*)(LDSL + LDS_MISC);
    if (threadIdx.x < 16) MISC[threadIdx.x] = 0u;
    __syncthreads();
    XcdBarrier bar = xcd_barrier_post((unsigned*)p.ws, MISC);
    PH();
    if (RUN(0)) REP(0) ph_prologue(q, lds, tidl, wave, lane, G);
    if (p.ws == nullptr) grid.sync();
    GSYNC();

    for (int l = 0; l < 2; ++l) {
        for (int stg = 0; stg < 3; ++stg) {
            const bool first = (l == 0 && stg == 0);
            const int cs = l * 3 + stg;
            const int rows = (l == 1 && stg == 2) ? MLAT : MALL;
            PH();
            if (RUN(1)) REP(1) ph_normmod(q, first ? q.x : HLAT, first ? q.ctx : HCTX, rows, l, stg, gw, ngw, lane);
            GSYNC();
            size_t ra_off, rb_off; int RM, RK; float rscale;
            if (stg != 1) {
                const int f = stg >> 1;
                PH();
                {
                    pg8::Gemm gm{ABUF, (const bf16_t*)(q.ws + WS_WUP) + (size_t)(l * 2 + f) * 2 * DFF * DM, rows, 2 * DFF, DM};
                    pg8::StaticOrder S; S.init(rows, 2 * DFF, G, (int)blockIdx.x);
                    EpiSwiglu E{(bf16_t*)(q.ws + WS_ACT)};
                    if (RUN(2)) REP(2) pg8::gemm_phase<EpiSwiglu, pg8::StaticOrder, true, true>(LDSL, gm, S, E);
                    if (first) {
                        const int rem = ((rows / 256) * 22) % G;
                        __syncthreads();
                        if (rem > 0 && (int)blockIdx.x >= rem) run_transposes(q, lds, wave, lane, 0x010u, ((int)blockIdx.x - rem) * 8 + wave, (G - rem) * 8);
                        else if (rem == 0) run_transposes(q, lds, wave, lane, 0x010u, (int)blockIdx.x * 8 + wave, G * 8);
                    }
                }
                ra_off = WS_ACT; rb_off = WS_WDN + (size_t)(l * 2 + f) * DM * DFF * 2; RM = rows; RK = DFF; rscale = 0.5f;
            } else if (l == 0) {
                PH();
                {
                    pg8::Gemm gm{ABUF, (const bf16_t*)(q.ws + WS_WEIN), MALL, 3840, DM};
                    pg8::StaticOrder S; S.init(MALL, 3840, G, (int)blockIdx.x);
                    EpiEvenIn E{(bf16_t*)(q.ws + WS_NAQK), (bf16_t*)(q.ws + WS_NAVT), (bf16_t*)(q.ws + WS_DNPRE), (bf16_t*)(q.ws + WS_Z), (float*)(q.ws + WS_AB)};
                    if (RUN(4)) REP(4) pg8::gemm_phase<EpiEvenIn, pg8::StaticOrder, true, true>(LDSL, gm, S, E);
                }
                GSYNC();
                PH();
                {
                    const int vcu = (G % 8 == 0) ? ((int)blockIdx.x % 8) * (G / 8) + (int)blockIdx.x / 8 : (int)blockIdx.x;
                    if (RUN(5)) REP(5) for (int t = vcu * 8 + wave; t < 3072; t += ngw) na_task(q, t, lane, (float*)(lds + wave * 12288));
                }
                PH();
                if (ngw == 2048) {
                    const int vcu = ((int)blockIdx.x % 8) * (G / 8) + (int)blockIdx.x / 8, gwv = vcu * 8 + wave;
                    if (RUN(6)) REP(6) {
                        if (gwv >= 1024) { for (int k = 0; k < 4; ++k) dn_conv_token4(q, ((gwv - 1024) * 4 + k) * 4, lane); }
                        else if (gwv < 512) dn_conv_token4(q, (4096 + gwv) * 4, lane);
                    }
                } else if (RUN(6)) REP(6) for (int m = gw * 4; m < MALL; m += ngw * 4) dn_conv_token4(q, m, lane);
                GSYNC();
                PH();
                if (RUN(7)) REP(7) for (int t = blockIdx.x; t < 1152; t += G) dn_prep_task(q, t, lds, tidl);
                GSYNC();
                PH();
                if (RUN(8)) REP(8) for (int t = blockIdx.x; t < 256; t += G) dn_scan_task(q, t, lds, tidl);
                GSYNC();
                PH();
                if (RUN(9)) REP(9) for (int m = gw; m < MALL; m += 2 * ngw) dn_comb_token2(q, m, m + ngw < MALL ? m + ngw : m, lane);
                ra_off = WS_A; rb_off = WS_WEOUT; RM = MALL; RK = DM; rscale = 1.0f;
            } else {
                for (int part = 0; part < 2; ++part) {
                    const int Mp = part ? 2048 : MLAT, Np = part ? 512 : 1536;
                    PH();
                    pg8::Gemm gm{ABUF + (part ? (size_t)MLAT * DM : 0), (const bf16_t*)(q.ws + WS_WOIN) + (part ? (size_t)1024 * DM : 0), Mp, Np, DM};
                    pg8::StaticOrder S; S.init(Mp, Np, G, part ? (int)((blockIdx.x + G / 2) % G) : (int)blockIdx.x);
                    EpiOddIn E{(bf16_t*)(q.ws + WS_SWQ), (bf16_t*)(q.ws + WS_SWK), (bf16_t*)(q.ws + WS_SWVT), part ? 64 : 0, part ? 4 : 0};
                    if (RUN(10)) REP(10) pg8::gemm_phase<EpiOddIn, pg8::StaticOrder, true, true>(LDSL, gm, S, E);
                }
                GSYNC();
                PH();
                {
                    const int vcu = (G % 8 == 0) ? ((int)blockIdx.x % 8) * (G / 8) + (int)blockIdx.x / 8 : (int)blockIdx.x;
                    if (RUN(11)) REP(11) for (int t = vcu; t < 512; t += G) { swa_block_task(q, t, lds, tidl); __syncthreads(); }
                }
                ra_off = WS_A; rb_off = WS_WOOUT; RM = MLAT; RK = DM; rscale = 1.0f;
            }
            GSYNC();
            PH();
            {
                pg8::Gemm gm{(const bf16_t*)(q.ws + ra_off), (const bf16_t*)(q.ws + rb_off), RM, DM, RK};
                pg8::StaticOrder S; S.init(RM, DM, G, (int)blockIdx.x);
                EpiResid E{first ? q.x : HLAT, first ? q.ctx : HCTX, HLAT, HCTX, MODP + (size_t)l * 9 * 9216 + (3 * stg + 2) * DM, rscale};
                if (RUN(3)) REP(3) pg8::gemm_phase<EpiResid, pg8::StaticOrder, true, true>(LDSL, gm, S, E);
                {
                    const int nbusy = (RM / 256) * 4 - G;
                    const unsigned tmask = cs == 0 ? 0x322u : (cs == 2 ? 0xCCCu : 0u);
                    if (tmask && nbusy > 0 && nbusy < G && (int)blockIdx.x >= nbusy) { __syncthreads(); run_transposes(q, lds, wave, lane, tmask, ((int)blockIdx.x - nbusy) * 8 + wave, (G - nbusy) * 8); }
                    else if (tmask && !(nbusy > 0 && nbusy < G)) { __syncthreads(); run_transposes(q, lds, wave, lane, tmask, (int)blockIdx.x * 8 + wave, G * 8); }
                }
            }
            GSYNC();
        }
    }
    PH();
    if (RUN(12)) REP(12) ph_final(q, gw, ngw, lane);
}

extern "C" void kernel_launch(void* const* d_in, const int* in_sizes, int n_in, void* d_out, int out_size, void* d_ws, size_t ws_size, hipStream_t stream) {
    static int grid = 0;
    if (grid == 0) {
        int dev = 0, cus = 0, per_cu = 0;
        hipGetDevice(&dev);
        hipDeviceGetAttribute(&cus, hipDeviceAttributeMultiprocessorCount, dev);
        hipFuncSetAttribute((const void*)mega_fwd, hipFuncAttributeMaxDynamicSharedMemorySize, LDS_BYTES);
        hipOccupancyMaxActiveBlocksPerMultiprocessor(&per_cu, (const void*)mega_fwd, NTHREADS, LDS_BYTES);
        if (per_cu < 1) per_cu = 1;
        grid = cus * per_cu;
        if (n_in != 20 || ws_size < 350 * MiB) fprintf(stderr, "kernel_launch: unexpected n_in %d / ws_size %zu\n", n_in, ws_size);
    }
    P p{};
    const float** pp = (const float**)&p;
    for (int i = 0; i < 20; ++i) pp[i] = (const float*)d_in[i];
    p.out = (float*)d_out; p.ws = (unsigned char*)d_ws;
    void* args[] = {&p};
    (void)hipMemsetAsync(d_ws, 0, 16384, stream);
    hipError_t e = hipLaunchCooperativeKernel((const void*)mega_fwd, dim3(grid), dim3(NTHREADS), args, LDS_BYTES, stream);
    if (e != hipSuccess) fprintf(stderr, "cooperative launch failed: %s (grid %d)\n", hipGetErrorString(e), grid);
}
```
